# Optimizing an MI355X kernel written in HIP

```python
import math
import jax, jax.numpy as jnp
from jax import lax
import numpy as np

D_MODEL = 1024
BATCH = 8
SEQ = 2048
DEPTH = 1
DEC_BATCH = 128
DEC_SEQ = 8
PAST_LEN = 16384
PAGE_SIZE = 128

N_META = 16
D_MIX = D_MODEL
N_HEADS_DN = 4
DK = 128
DV = 128
DK_TOT = N_HEADS_DN * DK
DV_TOT = N_HEADS_DN * DV
QKV_DIM = 2 * DK_TOT + DV_TOT
SHORT_CONV = 4
CHUNK = 64
C_CONV = D_MIX - DV_TOT
CONV_WIDTH = 31
D_FF = 2816
D_IN = QKV_DIM + DV_TOT + 2 * N_HEADS_DN + 2 * C_CONV
EPS = 1e-6

kernel_name = 'hybrid_gdn_conformer_conv_decoder_step'


def rmsnorm(x, g):
    x32 = x.astype(jnp.float32)
    y = x32 * lax.rsqrt(jnp.mean(x32 * x32, axis=-1, keepdims=True) + EPS)
    return (y * g.astype(jnp.float32)).astype(x.dtype)


def l2norm(x):
    return x * lax.rsqrt(jnp.sum(x * x, axis=-1, keepdims=True) + EPS)


def swiglu_half(h, g, w1, w3, w2):
    u = rmsnorm(h, g)
    return h + 0.5 * ((jax.nn.silu(u @ w1) * (u @ w3)) @ w2)


def causal_dwconv(x_ext, w):
    c = x_ext.shape[-1]
    return lax.conv_general_dilated(x_ext, w[:, None, :].astype(x_ext.dtype), window_strides=(1,),
                                    padding='VALID', dimension_numbers=('NWC', 'WIO', 'NWC'),
                                    feature_group_count=c)


def gated_delta_chunked(q, k, v, g, beta, s0, chunk):
    b, L, h, _ = q.shape
    pad = (-L) % chunk
    if pad:
        pz = lambda t: jnp.pad(t, [(0, 0), (0, pad)] + [(0, 0)] * (t.ndim - 2))
        q, k, v, g, beta = pz(q), pz(k), pz(v), pz(g), pz(beta)
    n = (L + pad) // chunk
    blk = lambda t: t.reshape(b, n, chunk, h, t.shape[-1]).transpose(0, 3, 1, 2, 4)
    q, k, v = blk(q), blk(k), blk(v)
    g = g.reshape(b, n, chunk, h).transpose(0, 3, 1, 2)
    beta = beta.reshape(b, n, chunk, h).transpose(0, 3, 1, 2)
    gc = jnp.cumsum(g, axis=-1)
    idx = jnp.arange(chunk)
    causal = idx[:, None] >= idx[None, :]
    strict = (idx[:, None] > idx[None, :]).astype(jnp.float32)
    decay = jnp.exp(jnp.where(causal, gc[..., :, None] - gc[..., None, :], -jnp.inf))
    kb = k * beta[..., None]
    vb = v * beta[..., None]
    a_mat = jnp.einsum('bhncd,bhnsd->bhncs', kb, k) * decay * strict
    m_mat = jnp.eye(chunk, dtype=jnp.float32) + a_mat
    rhs = jnp.concatenate([vb, kb * jnp.exp(gc)[..., None]], axis=-1)
    sol = lax.linalg.triangular_solve(m_mat, rhs, left_side=True, lower=True, unit_diagonal=True)
    u_c, w_c = sol[..., :DV], sol[..., DV:]
    att = jnp.einsum('bhncd,bhnsd->bhncs', q, k) * decay

    def step(s, xs):
        q_i, k_i, u_i, w_i, att_i, gc_i = xs
        v_new = u_i - jnp.einsum('bhck,bhkv->bhcv', w_i, s)
        o = (jnp.einsum('bhck,bhkv->bhcv', q_i * jnp.exp(gc_i)[..., None], s)
             + jnp.einsum('bhcs,bhsv->bhcv', att_i, v_new))
        g_last = gc_i[..., -1]
        s = (s * jnp.exp(g_last)[..., None, None]
             + jnp.einsum('bhck,bhcv->bhkv', k_i * jnp.exp(g_last[..., None] - gc_i)[..., None], v_new))
        return s, o

    first = lambda t: jnp.moveaxis(t, 2, 0)
    s_fin, o = lax.scan(step, s0, (first(q), first(k), first(u_c), first(w_c), first(att), first(gc)))
    o = o.transpose(1, 0, 3, 2, 4).reshape(b, n * chunk, h, DV)[:, :L]
    return o, s_fin


def hybrid_mixer(h, s_delta, s_qkv, s_conv, n_lead, norm_g, w_in, qkv_conv_w, a_log, dt_bias,
                 o_norm_g, conv_w, conv_b, conv_norm_g, w_out):
    f32 = jnp.float32
    bn, L, _ = h.shape
    u = rmsnorm(h, norm_g)
    p = u @ w_in
    cut = np.cumsum([QKV_DIM, DV_TOT, N_HEADS_DN, N_HEADS_DN]).tolist()
    qkv_pre, z, b_raw, a_raw, glu = jnp.split(p, cut, axis=-1)
    qkv_ext = jnp.concatenate([s_qkv.astype(p.dtype), qkv_pre], axis=1)
    new_s_qkv = qkv_ext[:, -(SHORT_CONV - 1):]
    qkv = jax.nn.silu(causal_dwconv(qkv_ext, qkv_conv_w)).astype(f32)
    q, k, v = jnp.split(qkv, [DK_TOT, 2 * DK_TOT], axis=-1)
    q = l2norm(q.reshape(bn, L, N_HEADS_DN, DK)) * (DK ** -0.5)
    k = l2norm(k.reshape(bn, L, N_HEADS_DN, DK))
    v = v.reshape(bn, L, N_HEADS_DN, DV)
    beta = jax.nn.sigmoid(b_raw.astype(f32))
    g = -jnp.exp(a_log.astype(f32)) * jax.nn.softplus(a_raw.astype(f32) + dt_bias.astype(f32))
    s = s_delta.astype(f32)
    segments = [(0, n_lead), (n_lead, L)] if n_lead > 0 else [(0, L)]
    outs = []
    for lo, hi in segments:
        o_seg, s = gated_delta_chunked(q[:, lo:hi], k[:, lo:hi], v[:, lo:hi], g[:, lo:hi], beta[:, lo:hi],
                                       s, min(CHUNK, hi - lo))
        outs.append(o_seg)
    o = jnp.concatenate(outs, axis=1)
    o = rmsnorm(o, o_norm_g) * jax.nn.silu(z.astype(f32).reshape(bn, L, N_HEADS_DN, DV))
    o = o.reshape(bn, L, DV_TOT).astype(h.dtype)
    val, gate = jnp.split(glu, 2, axis=-1)
    c_in = val * jax.nn.sigmoid(gate)
    c_ext = jnp.concatenate([s_conv.astype(c_in.dtype), c_in], axis=1)
    new_s_conv = c_ext[:, -(CONV_WIDTH - 1):]
    c = causal_dwconv(c_ext, conv_w) + conv_b
    c = jax.nn.silu(rmsnorm(c, conv_norm_g))
    mix = jnp.concatenate([o, c], axis=-1) @ w_out
    return h + mix, s.astype(h.dtype), new_s_qkv, new_s_conv


def decoder_layer(h, s_delta, s_qkv, s_conv, n_lead, ffn1, mixp, ffn2):
    h = swiglu_half(h, *ffn1)
    h, sd, sq, sc = hybrid_mixer(h, s_delta, s_qkv, s_conv, n_lead, *mixp)
    h = swiglu_half(h, *ffn2)
    return h, sd, sq, sc


def setup_inputs(seed: int = 0) -> dict:
    key = jax.random.key(seed)
    ks = jax.random.split(key, 25)
    f32 = jnp.float32
    nrm = lambda i, shape, scale: jax.random.normal(ks[i], shape, f32) * scale
    gain = lambda i, shape: 1.0 + 0.05 * jax.random.normal(ks[i], shape, f32)
    a_log = jnp.log(jax.random.uniform(ks[13], (DEPTH, N_HEADS_DN), f32, 1.0, 16.0))
    dt = jnp.exp(jax.random.uniform(ks[14], (DEPTH, N_HEADS_DN), f32, math.log(1e-3), math.log(1e-1)))
    dt_bias = dt + jnp.log(-jnp.expm1(-dt))
    return {
        'x_prompt': nrm(0, (BATCH, SEQ, D_MODEL), 1.0),
        'x_sample': nrm(1, (DEC_BATCH, DEC_SEQ, D_MODEL), 1.0),
        'state_delta': nrm(2, (DEPTH, DEC_BATCH, N_HEADS_DN, DK, DV), 0.5),
        'state_qkv_conv': nrm(3, (DEPTH, DEC_BATCH, SHORT_CONV - 1, QKV_DIM), 1.0),
        'state_conv': nrm(4, (DEPTH, DEC_BATCH, CONV_WIDTH - 1, C_CONV), 1.0),
        'meta_tokens': nrm(5, (N_META, D_MODEL), 1.0),
        'ffn1_norm': gain(6, (DEPTH, D_MODEL)),
        'ffn1_w1': nrm(7, (DEPTH, D_MODEL, D_FF), D_MODEL ** -0.5),
        'ffn1_w3': nrm(8, (DEPTH, D_MODEL, D_FF), D_MODEL ** -0.5),
        'ffn1_w2': nrm(9, (DEPTH, D_FF, D_MODEL), D_FF ** -0.5),
        'mix_norm': gain(10, (DEPTH, D_MODEL)),
        'w_in': nrm(11, (DEPTH, D_MODEL, D_IN), D_MODEL ** -0.5),
        'qkv_conv_w': nrm(12, (DEPTH, SHORT_CONV, QKV_DIM), SHORT_CONV ** -0.5),
        'a_log': a_log,
        'dt_bias': dt_bias,
        'o_norm': gain(15, (DEPTH, DV)),
        'conv_w': nrm(16, (DEPTH, CONV_WIDTH, C_CONV), CONV_WIDTH ** -0.5),
        'conv_b': nrm(17, (DEPTH, C_CONV), 0.02),
        'conv_norm': gain(18, (DEPTH, C_CONV)),
        'w_out': nrm(19, (DEPTH, D_MIX, D_MODEL), D_MIX ** -0.5),
        'ffn2_norm': gain(20, (DEPTH, D_MODEL)),
        'ffn2_w1': nrm(21, (DEPTH, D_MODEL, D_FF), D_MODEL ** -0.5),
        'ffn2_w3': nrm(22, (DEPTH, D_MODEL, D_FF), D_MODEL ** -0.5),
        'ffn2_w2': nrm(23, (DEPTH, D_FF, D_MODEL), D_FF ** -0.5),
        'final_norm': gain(24, (D_MODEL,)),
    }


def reference(x_prompt, x_sample, state_delta, state_qkv_conv, state_conv, meta_tokens,
              ffn1_norm, ffn1_w1, ffn1_w3, ffn1_w2, mix_norm, w_in, qkv_conv_w, a_log, dt_bias,
              o_norm, conv_w, conv_b, conv_norm, w_out, ffn2_norm, ffn2_w1, ffn2_w3, ffn2_w2, final_norm):
    dt = x_prompt.dtype
    bp = x_prompt.shape[0]
    meta = jnp.broadcast_to(meta_tokens.astype(dt)[None], (bp, N_META, D_MODEL))
    hp = jnp.concatenate([meta, x_prompt], axis=1)
    hs = x_sample
    dp, qp, cp, ds, qs, cs = [], [], [], [], [], []
    for l in range(DEPTH):
        ffn1 = (ffn1_norm[l], ffn1_w1[l], ffn1_w3[l], ffn1_w2[l])
        ffn2 = (ffn2_norm[l], ffn2_w1[l], ffn2_w3[l], ffn2_w2[l])
        mixp = (mix_norm[l], w_in[l], qkv_conv_w[l], a_log[l], dt_bias[l], o_norm[l],
                conv_w[l], conv_b[l], conv_norm[l], w_out[l])
        zd = jnp.zeros((bp, N_HEADS_DN, DK, DV), dt)
        zq = jnp.zeros((bp, SHORT_CONV - 1, QKV_DIM), dt)
        zc = jnp.zeros((bp, CONV_WIDTH - 1, C_CONV), dt)
        hp, sd, sq, sc = decoder_layer(hp, zd, zq, zc, N_META, ffn1, mixp, ffn2)
        dp.append(sd); qp.append(sq); cp.append(sc)
        hs, sd, sq, sc = decoder_layer(hs, state_delta[l], state_qkv_conv[l], state_conv[l], 0, ffn1, mixp, ffn2)
        ds.append(sd); qs.append(sq); cs.append(sc)
    y_prompt = rmsnorm(hp, final_norm)[:, N_META:]
    y_sample = rmsnorm(hs, final_norm)
    return (y_prompt, y_sample, jnp.stack(dp), jnp.stack(qp), jnp.stack(cp),
            jnp.stack(ds), jnp.stack(qs), jnp.stack(cs))
```

```cpp
#include <hip/hip_runtime.h>
#include <cstdio>
#include <cstdint>
namespace pg8 {
#define PG8_LAS __attribute__((address_space(3)))
typedef unsigned short bf16_t;
typedef short bf16x8 __attribute__((ext_vector_type(8)));
typedef float f32x4 __attribute__((ext_vector_type(4)));
typedef unsigned u32x4 __attribute__((ext_vector_type(4)));
constexpr int BM = 256, BK = 64, HALF = 128, HTB = HALF * BK * 2  , STAGE_BYTES = 8 * HTB, NXCD = 8, WGM = 8;

__host__ __device__ __forceinline__ int lds_byte(int r, int c) { const int st = (r >> 4) * 2 + (c >> 5), rr = r & 15, cc = c & 31, ob = rr * 64 + cc * 2; return st * 1024 + (ob ^ (((ob >> 9) & 1) << 5)); }
__host__ __device__ __forceinline__ void stage_rc(int b, int& R, int& C) { const int st = b / 1024, sb = b % 1024, swz = sb ^ (((sb >> 9) & 1) << 5); R = (st >> 1) * 16 + swz / 64; C = (st & 1) * 32 + (swz % 64) / 2; }
__host__ __device__ __forceinline__ int perm32(int rho) { const int n = rho >> 4, i = rho & 15; return 8 * (i >> 2) + 4 * n + (i & 3); }

struct Unit { int pm, pn; };
struct Gemm { const bf16_t* A; const bf16_t* Bt; int M, N, K; };

struct StaticOrder {
    int nM, nN, nwg, G, c;
    __host__ __device__ void init(int M, int N, int G_, int c_) { nM = M / BM; nN = N / BM; nwg = nM * nN; G = G_; c = c_; }
    __host__ __device__ bool next(int i, Unit& u) const {
        const long L = (long)i * G + c; if (L >= nwg) return false;
        int wgid = (int)L; { const int q = nwg / NXCD, r = nwg % NXCD, xcd = wgid % NXCD, off = wgid / NXCD; wgid = (xcd < r ? xcd * (q + 1) : r * (q + 1) + (xcd - r) * q) + off; }
        const int nig = WGM * nN, gid = wgid / nig, fm = gid * WGM, gsz = (nM - fm) < WGM ? (nM - fm) : WGM;
        u.pm = fm + ((wgid % nig) % gsz); u.pn = (wgid % nig) / gsz; return true;
    }
    __device__ __forceinline__ void a_ready(const Unit&) const {}
    __device__ __forceinline__ void done(const Unit&) const {}
};

typedef float f32x2 __attribute__((ext_vector_type(2)));
typedef __bf16 bf16x2v __attribute__((ext_vector_type(2)));
__device__ __forceinline__ unsigned pk2(float lo, float hi) { f32x2 v = {lo, hi}; bf16x2v b = __builtin_convertvector(v, bf16x2v); return __builtin_bit_cast(unsigned, b); }
__device__ __forceinline__ float fsigmoid(float x) { return __builtin_amdgcn_rcpf(1.0f + __expf(-x)); }
__device__ __forceinline__ float fsilu(float x) { return x * fsigmoid(x); }
__device__ __forceinline__ float row_rstd(const float* ss, int row) {
    const f32x4* p = (const f32x4*)(ss + (size_t)row * 16);
    const f32x4 a = p[0], b = p[1], c = p[2], d = p[3];
    const float s = (((a[0] + a[1]) + (a[2] + a[3])) + ((b[0] + b[1]) + (b[2] + b[3]))) + (((c[0] + c[1]) + (c[2] + c[3])) + ((d[0] + d[1]) + (d[2] + d[3])));
    return 1.0f / sqrtf(s * (1.0f / 1024.0f) + 1e-6f);
}
struct EpiSwiGLU {
    static constexpr bool PERM = true, AFTER_DRAIN = false;
    bf16_t* O; const float* ss;
    __device__ __forceinline__ void operator()(const f32x4 (&acc)[2][2][4][2], const Unit& u, int wr, int wc, int fr, int fq) const {
        const int row0 = u.pm * BM + wr * 64 + fr, col0 = u.pn * 128 + wc * 32 + 8 * fq;
#pragma unroll
        for (int ai = 0; ai < 2; ++ai)
#pragma unroll
            for (int m = 0; m < 4; ++m) { const int row = row0 + ai * HALF + m * 16; const float rs = row_rstd(ss, row);
                const f32x4 g0 = acc[ai][0][m][0] * rs, g1 = acc[ai][0][m][1] * rs, u0 = acc[ai][1][m][0] * rs, u1 = acc[ai][1][m][1] * rs;
                u32x4 w; w.x = pk2(fsilu(g0[0]) * u0[0], fsilu(g0[1]) * u0[1]); w.y = pk2(fsilu(g0[2]) * u0[2], fsilu(g0[3]) * u0[3]);
                w.z = pk2(fsilu(g1[0]) * u1[0], fsilu(g1[1]) * u1[1]); w.w = pk2(fsilu(g1[2]) * u1[2], fsilu(g1[3]) * u1[3]);
                *(u32x4*)(O + (size_t)row * 2816 + col0) = w; }
    }
};
struct EpiInProj {
    static constexpr bool PERM = true, AFTER_DRAIN = false;
    bf16_t* QKV; bf16_t* Z; bf16_t* CIN; float* BA; const float* ss;
    __device__ __forceinline__ void operator()(const f32x4 (&acc)[2][2][4][2], const Unit& u, int wr, int wc, int fr, int fq) const {
        const int row0 = u.pm * BM + wr * 64 + fr, cw = wc * 32 + 8 * fq;
#pragma unroll
        for (int ai = 0; ai < 2; ++ai)
#pragma unroll
            for (int m = 0; m < 4; ++m) { const int row = row0 + ai * HALF + m * 16; const float rs = row_rstd(ss, row);
                if (u.pn < 8) {
                    bf16_t* rowp = (u.pn < 6) ? QKV + (size_t)row * 1536 + u.pn * 256 + cw : Z + (size_t)row * 512 + (u.pn - 6) * 256 + cw;
#pragma unroll
                    for (int bj = 0; bj < 2; ++bj) { const f32x4 v0 = acc[ai][bj][m][0] * rs, v1 = acc[ai][bj][m][1] * rs;
                        u32x4 w; w.x = pk2(v0[0], v0[1]); w.y = pk2(v0[2], v0[3]); w.z = pk2(v1[0], v1[1]); w.w = pk2(v1[2], v1[3]);
                        *(u32x4*)(rowp + bj * HALF) = w; }
                } else if (u.pn < 12) {
                    const f32x4 a0 = acc[ai][0][m][0] * rs, a1 = acc[ai][0][m][1] * rs, g0 = acc[ai][1][m][0] * rs, g1 = acc[ai][1][m][1] * rs;
                    u32x4 w; w.x = pk2(a0[0] * fsigmoid(g0[0]), a0[1] * fsigmoid(g0[1])); w.y = pk2(a0[2] * fsigmoid(g0[2]), a0[3] * fsigmoid(g0[3]));
                    w.z = pk2(a1[0] * fsigmoid(g1[0]), a1[1] * fsigmoid(g1[1])); w.w = pk2(a1[2] * fsigmoid(g1[2]), a1[3] * fsigmoid(g1[3]));
                    *(u32x4*)(CIN + (size_t)row * 512 + (u.pn - 8) * 128 + cw) = w;
                } else if (wc == 0 && fq == 0) {
                    *(f32x4*)(BA + (size_t)row * 8) = acc[ai][0][m][0] * rs; *(f32x4*)(BA + (size_t)row * 8 + 4) = acc[ai][0][m][1] * rs;
                }
            }
    }
};
struct EpiResid {
    static constexpr bool PERM = false, AFTER_DRAIN = false;
    float* H; bf16_t* U; float* SS; float scale; int h0; const float* xp; const float* xs; const float* meta;
    __device__ __forceinline__ void operator()(const f32x4 (&acc)[2][2][4][2], const Unit& u, int wr, int wc, int fr, int fq) const {
        const int row0 = u.pm * BM + wr * 64 + fr, col0 = u.pn * BM + wc * 32 + 4 * fq;
#pragma unroll
        for (int ai = 0; ai < 2; ++ai)
#pragma unroll
            for (int m = 0; m < 4; ++m) { const int row = row0 + ai * HALF + m * 16;
                const float* rp = H + (size_t)row * 1024;
                if (h0) { if (row < 16512) { const int b = row / 2064, t = row - b * 2064; rp = (t < 16) ? meta + t * 1024 : xp + ((size_t)b * 2048 + (t - 16)) * 1024; }
                          else if (row < 17536) rp = xs + (size_t)(row - 16512) * 1024; else rp = nullptr; }
                float s = 0.f;
#pragma unroll
                for (int bj = 0; bj < 2; ++bj)
#pragma unroll
                    for (int n = 0; n < 2; ++n) { const int c = col0 + bj * HALF + n * 16;
                        const f32x4 r = rp ? *(const f32x4*)(rp + c) : (f32x4){0.f, 0.f, 0.f, 0.f};
                        const f32x4 v = r + acc[ai][bj][m][n] * scale;
                        *(f32x4*)(H + (size_t)row * 1024 + c) = v;
                        s += (v[0] * v[0] + v[1] * v[1]) + (v[2] * v[2] + v[3] * v[3]);
                        if (U) { unsigned long long w = (unsigned long long)pk2(v[0], v[1]) | ((unsigned long long)pk2(v[2], v[3]) << 32); *(unsigned long long*)(U + (size_t)row * 1024 + c) = w; } }
                if (SS) { s += __shfl_xor(s, 16); s += __shfl_xor(s, 32); if (fq == 0) SS[(size_t)row * 16 + u.pn * 4 + wc] = s; }
            }
    }
};

template <class Epi, class Sched, bool ALIGN_EPI = false, bool SP2 = false>
__device__ __forceinline__ void gemm_phase(PG8_LAS unsigned char* lds, const Gemm g, const Sched& S, const Epi& E) {
    const int tid = threadIdx.x, wid = __builtin_amdgcn_readfirstlane(tid >> 6), lane = tid & 63, wr = wid >> 2, wc = wid & 3, fr = lane & 15, fq = lane >> 4;
    const int K = g.K, nt = K / BK;
    unsigned voffA[2], voffB[2];
#pragma unroll
    for (int i = 0; i < 2; ++i) { int R, C; stage_rc(tid * 16 + i * 8192, R, C); const int Rb = Epi::PERM ? ((R & ~31) + perm32(R & 31)) : R;
        voffA[i] = (unsigned)(R * K + C) * 2u; voffB[i] = (unsigned)(Rb * K + C) * 2u; }
    const size_t kstep = (size_t)(BK * 2);
    const size_t hstep = (size_t)HALF * K * 2;
    const size_t tstep = 2 * hstep;
    const unsigned ldsw = (unsigned)wid * 1024u;
    const int aoff = lds_byte(wr * 64 + fr, fq * 8), boff = lds_byte(wc * 32 + fr, fq * 8);
#define PG8_SA(b, h) (((b) * 2 + (h)) * HTB)
#define PG8_SB(b, h) ((4 + (b) * 2 + (h)) * HTB)
#define PG8_STAGE(bufoff, gbase, voff) do { _Pragma("unroll") for (int _i = 0; _i < 2; ++_i) \
        __builtin_amdgcn_global_load_lds((const unsigned*)((const char*)(gbase) + (voff)[_i]), (PG8_LAS unsigned*)(lds + (bufoff) + ldsw + _i * 8192), 16, 0, 0); } while (0)
#define PG8_LDA(dst, b, h) do { _Pragma("unroll") for (int m = 0; m < 4; ++m) _Pragma("unroll") for (int k = 0; k < 2; ++k) dst[m][k] = *(const PG8_LAS bf16x8*)(lds + PG8_SA(b, h) + aoff + m * 2048 + k * 1024); } while (0)
#define PG8_LDB(dst, b, h) do { _Pragma("unroll") for (int n = 0; n < 2; ++n) _Pragma("unroll") for (int k = 0; k < 2; ++k) dst[n][k] = *(const PG8_LAS bf16x8*)(lds + PG8_SB(b, h) + boff + n * 2048 + k * 1024); } while (0)
#define PG8_MMA(ai, bj, At, Bt) do { __builtin_amdgcn_s_setprio(1); _Pragma("unroll") for (int m = 0; m < 4; ++m) _Pragma("unroll") for (int n = 0; n < 2; ++n) _Pragma("unroll") for (int k = 0; k < 2; ++k) \
        acc[ai][bj][m][n] = __builtin_amdgcn_mfma_f32_16x16x32_bf16(Bt[n][k], At[m][k], acc[ai][bj][m][n], 0, 0, 0); __builtin_amdgcn_s_setprio(0); } while (0)
#define PG8_WAIT_V(n) asm volatile("s_waitcnt vmcnt(" #n ")" ::: "memory")
#define PG8_WAIT_L(n) asm volatile("s_waitcnt lgkmcnt(" #n ")" ::: "memory")
#define PG8_BAR __builtin_amdgcn_s_barrier()
#define PG8_SCHED __builtin_amdgcn_sched_barrier(0)
    Unit cur, nxt; int ui = 0;
    if (!S.next(0, cur)) return;
    f32x4 acc[2][2][4][2];
#pragma unroll
    for (int a = 0; a < 2; ++a)
#pragma unroll
        for (int b = 0; b < 2; ++b)
#pragma unroll
            for (int m = 0; m < 4; ++m)
#pragma unroll
                for (int n = 0; n < 2; ++n) acc[a][b][m][n] = (f32x4){0.f, 0.f, 0.f, 0.f};
    bf16x8 At[4][2], B0[2][2], B1[2][2];
    const char* cA = (const char*)g.A + (size_t)cur.pm * tstep; const char* cB = (const char*)g.Bt + (size_t)cur.pn * tstep;
    S.a_ready(cur);
    if constexpr (SP2) {
        PG8_STAGE(PG8_SB(0, 0), cB, voffB); PG8_STAGE(PG8_SB(0, 1), cB + hstep, voffB); PG8_STAGE(PG8_SA(0, 0), cA, voffA); PG8_STAGE(PG8_SA(0, 1), cA + hstep, voffA);
        if (wr == 1) PG8_BAR;
        PG8_WAIT_V(2); PG8_BAR;
        PG8_STAGE(PG8_SB(1, 0), cB + kstep, voffB); PG8_STAGE(PG8_SA(1, 0), cA + kstep, voffA); PG8_STAGE(PG8_SB(1, 1), cB + hstep + kstep, voffB);
        PG8_WAIT_V(6); PG8_BAR;
    } else {
        PG8_STAGE(PG8_SB(0, 0), cB, voffB); PG8_STAGE(PG8_SA(0, 0), cA, voffA); PG8_STAGE(PG8_SB(0, 1), cB + hstep, voffB); PG8_STAGE(PG8_SA(0, 1), cA + hstep, voffA);
        if (wr == 1) PG8_BAR;
        PG8_WAIT_V(4); PG8_BAR;
        PG8_STAGE(PG8_SB(1, 0), cB + kstep, voffB); PG8_STAGE(PG8_SA(1, 0), cA + kstep, voffA); PG8_STAGE(PG8_SB(1, 1), cB + hstep + kstep, voffB);
        PG8_WAIT_V(6); PG8_BAR;
    }
    for (;;) {
        const bool has_next = S.next(ui + 1, nxt);
        const char* nA = has_next ? (const char*)g.A + (size_t)nxt.pm * tstep : cA; const char* nB = has_next ? (const char*)g.Bt + (size_t)nxt.pn * tstep : cB;
        for (int t = 0; t < nt; t += 2) {
            const bool last = (t == nt - 2);
            const char* a1 = cA + (size_t)(t + 1) * kstep;
            const char* a2 = last ? nA : cA + (size_t)(t + 2) * kstep; const char* b2 = last ? nB : cB + (size_t)(t + 2) * kstep;
            const char* a3 = a2 + kstep; const char* b3 = b2 + kstep;
            if (last && has_next) S.a_ready(nxt);
            if constexpr (SP2) {
            PG8_LDB(B0, 0, 0); PG8_LDB(B1, 0, 1); PG8_SCHED; PG8_LDA(At, 0, 0); PG8_STAGE(PG8_SA(1, 1), a1 + hstep, voffA);
            PG8_WAIT_V(8); PG8_WAIT_L(0); PG8_BAR; PG8_MMA(0, 0, At, B0); PG8_MMA(0, 1, At, B1); PG8_BAR; PG8_SCHED;
            PG8_LDA(At, 0, 1); PG8_STAGE(PG8_SB(0, 0), b2, voffB); PG8_STAGE(PG8_SB(0, 1), b2 + hstep, voffB); PG8_STAGE(PG8_SA(0, 0), a2, voffA);
            PG8_WAIT_V(8); PG8_WAIT_L(0); PG8_BAR; PG8_MMA(1, 0, At, B0); PG8_MMA(1, 1, At, B1); PG8_BAR; PG8_SCHED;
            PG8_LDB(B0, 1, 0); PG8_LDB(B1, 1, 1); PG8_SCHED; PG8_LDA(At, 1, 0); PG8_STAGE(PG8_SA(0, 1), a2 + hstep, voffA);
            PG8_WAIT_V(8); PG8_WAIT_L(0); PG8_BAR; PG8_MMA(0, 0, At, B0); PG8_MMA(0, 1, At, B1); PG8_BAR; PG8_SCHED;
            PG8_LDA(At, 1, 1); PG8_STAGE(PG8_SB(1, 0), b3, voffB); PG8_STAGE(PG8_SB(1, 1), b3 + hstep, voffB); PG8_STAGE(PG8_SA(1, 0), a3, voffA);
            PG8_WAIT_V(8); PG8_WAIT_L(0); PG8_BAR; PG8_MMA(1, 0, At, B0); PG8_MMA(1, 1, At, B1); PG8_BAR; PG8_SCHED;
            } else {
            PG8_LDB(B0, 0, 0); PG8_SCHED; PG8_LDA(At, 0, 0); PG8_STAGE(PG8_SA(1, 1), a1 + hstep, voffA);
            PG8_WAIT_L(8); PG8_BAR; PG8_WAIT_L(0); PG8_MMA(0, 0, At, B0); PG8_BAR; PG8_SCHED;
            PG8_LDB(B1, 0, 1); PG8_STAGE(PG8_SB(0, 0), b2, voffB);
            PG8_BAR; PG8_WAIT_L(0); PG8_MMA(0, 1, At, B1); PG8_BAR;
            PG8_LDA(At, 0, 1); PG8_STAGE(PG8_SA(0, 0), a2, voffA);
            PG8_BAR; PG8_WAIT_L(0); PG8_MMA(1, 0, At, B0); PG8_BAR; PG8_SCHED;
            PG8_STAGE(PG8_SB(0, 1), b2 + hstep, voffB);
            PG8_WAIT_V(6); PG8_BAR; PG8_MMA(1, 1, At, B1); PG8_BAR;
            PG8_LDB(B0, 1, 0); PG8_SCHED; PG8_LDA(At, 1, 0); PG8_STAGE(PG8_SA(0, 1), a2 + hstep, voffA);
            PG8_WAIT_L(8); PG8_BAR; PG8_WAIT_L(0); PG8_MMA(0, 0, At, B0); PG8_BAR; PG8_SCHED;
            PG8_LDB(B1, 1, 1); PG8_STAGE(PG8_SB(1, 0), b3, voffB);
            PG8_BAR; PG8_WAIT_L(0); PG8_MMA(0, 1, At, B1); PG8_BAR;
            PG8_LDA(At, 1, 1); PG8_STAGE(PG8_SA(1, 0), a3, voffA);
            PG8_BAR; PG8_WAIT_L(0); PG8_MMA(1, 0, At, B0); PG8_BAR; PG8_SCHED;
            PG8_STAGE(PG8_SB(1, 1), b3 + hstep, voffB);
            PG8_WAIT_V(6); PG8_BAR; PG8_MMA(1, 1, At, B1); PG8_BAR;
            }
        }
        if constexpr (ALIGN_EPI) { if (wr == 0) PG8_BAR; }
        if constexpr (!Epi::AFTER_DRAIN) { E(acc, cur, wr, wc, fr, fq); S.done(cur); }
        if (!has_next) break;
#pragma unroll
        for (int a = 0; a < 2; ++a)
#pragma unroll
            for (int b = 0; b < 2; ++b)
#pragma unroll
                for (int m = 0; m < 4; ++m)
#pragma unroll
                    for (int n = 0; n < 2; ++n) acc[a][b][m][n] = (f32x4){0.f, 0.f, 0.f, 0.f};
        cur = nxt; cA = nA; cB = nB; ++ui;
        if constexpr (ALIGN_EPI) { if (wr == 1) PG8_BAR; }
    }
    PG8_WAIT_V(0);
    if constexpr (!ALIGN_EPI) { if (wr == 0) PG8_BAR; }
    PG8_BAR;
    if constexpr (Epi::AFTER_DRAIN) { E.fused(acc, cur, wr, wc, fr, fq, lds, wid, lane); S.done(cur); }
#undef PG8_SA
#undef PG8_SB
#undef PG8_STAGE
#undef PG8_LDA
#undef PG8_LDB
#undef PG8_MMA
#undef PG8_WAIT_V
#undef PG8_WAIT_L
#undef PG8_BAR
#undef PG8_SCHED
}
}

constexpr int NWAVES = 8;
constexpr int D = 1024, DFF = 2816, LP = 2064, MPR = 8 * LP  , MREAL = MPR + 1024  , MPAD = 17664  ;
constexpr int NIN = 3080, NINP = 3328;
constexpr float EPS = 1e-6f;
constexpr size_t MiB = 1u << 20;
constexpr size_t WS_CTL = 0, CTL_ZERO_BYTES = 1 * MiB;
constexpr size_t WS_W13A = 1 * MiB, WS_W2A = 12 * MiB, WS_WIN = 17 * MiB + MiB / 2, WS_WOUT = 24 * MiB, WS_W13B = 26 * MiB, WS_W2B = 37 * MiB;
constexpr size_t WS_BA = 42 * MiB + MiB / 2;
constexpr size_t WS_H = 44 * MiB;
constexpr size_t WS_UA = 113 * MiB;
constexpr size_t WS_HID = 147 * MiB + MiB / 2;
constexpr size_t WS_Z = WS_HID, WS_CIN = WS_Z + (size_t)MPAD * 512 * 2;
constexpr size_t WS_NW = 182 * MiB, WS_QG = 198 * MiB, WS_KDT = 214 * MiB, WS_UT = 230 * MiB;
constexpr size_t WS_SSA = 246 * MiB, WS_SSB = 247 * MiB + MiB / 4;
constexpr size_t WS_DL = 248 * MiB + MiB / 2;
constexpr size_t WS_ATT = 1 * MiB;
constexpr size_t WS_SM = 9 * MiB + MiB / 4;
constexpr size_t SM_STRIDE = 16896, WS_END = 256 * MiB;
static_assert(WS_W2A - WS_W13A == (size_t)5632 * 1024 * 2 && WS_WIN - WS_W2A == (size_t)1024 * 2816 * 2 && WS_WOUT - WS_WIN == (size_t)NINP * 1024 * 2 && WS_W13B - WS_WOUT == (size_t)1024 * 1024 * 2 && WS_W2B - WS_W13B == (size_t)5632 * 1024 * 2 && WS_W2B + (size_t)1024 * 2816 * 2 <= WS_BA, "weights map");
static_assert(WS_BA + (size_t)MPAD * 8 * 4 <= WS_H && WS_H + (size_t)MPAD * 1024 * 4 == WS_UA && WS_UA + (size_t)MPAD * 1024 * 2 == WS_HID && WS_HID + (size_t)MPAD * 2816 * 2 <= WS_SSA, "activation map");
static_assert(WS_CIN + (size_t)MPAD * 512 * 2 <= WS_NW && WS_UT + 16 * MiB <= WS_SSA && WS_SSA + (size_t)MPAD * 64 <= WS_SSB && WS_SSB + (size_t)MPAD * 64 <= WS_DL && WS_DL + 2048 * 4 <= WS_END, "mixer overlay map");
static_assert(WS_ATT + 1024 * 8192 <= WS_SM && WS_SM + 544 * SM_STRIDE <= WS_WOUT, "scan small-unit map");
constexpr size_t OUT_YP = 0, OUT_YS = 16777216, OUT_DP = 17825792, OUT_QP = 18350080, OUT_CP = 18386944, OUT_DS = 18509824, OUT_QS = 26898432, OUT_CS = 27488256, OUT_TOTAL = 29454336;
static_assert((size_t)MPAD * 1536 * 2 <= OUT_YS * 4, "QKV scratch fits the y_prompt range");
constexpr int CW_BAR = 4096;
constexpr int RING_OFF = 0, RING_BYTES = 131072;
constexpr int LDSCTL_OFF = RING_BYTES, MISC_OFF = LDSCTL_OFF + 320;
constexpr int LDS_BYTES = 147456;
#define GAS __attribute__((address_space(1)))
#define LAS __attribute__((address_space(3)))
typedef unsigned short bf16;
typedef unsigned v4u __attribute__((ext_vector_type(4)));
typedef float f32x4 __attribute__((ext_vector_type(4)));
typedef short bf16x8 __attribute__((ext_vector_type(8)));
typedef GAS unsigned gu32;
typedef GAS unsigned long long gu64;
#define RLX_AGENT __ATOMIC_RELAXED, __HIP_MEMORY_SCOPE_AGENT
#define LDS_WAIT() asm volatile("s_waitcnt lgkmcnt(0)" ::: "memory")
#define VM_WAIT() asm volatile("s_waitcnt vmcnt(0)" ::: "memory")
__device__ __forceinline__ unsigned long long rt() { return __builtin_amdgcn_s_memrealtime(); }

#define XB_TMO      128
#define XB_XCNT(j)  (256  + 64 * (j))
#define XB_XSUB(j)  (1280 + 64 * (j))
#define XB_XGEN(j)  (2304 + 64 * (j))
#define XB_TOP      3328
#define XB_TOPGEN   3392
#define XCD_BAR_WORDS 3456
#define XB_SPIN_CAP (1u << 18)

__device__ __forceinline__ unsigned xb_ld(unsigned* p)              { return __hip_atomic_load(p, __ATOMIC_RELAXED, __HIP_MEMORY_SCOPE_AGENT); }
__device__ __forceinline__ unsigned xb_add(unsigned* p, unsigned v) { return __hip_atomic_fetch_add(p, v, __ATOMIC_RELAXED, __HIP_MEMORY_SCOPE_AGENT); }
__device__ __forceinline__ unsigned xb_xcc_id() { return (unsigned)__builtin_amdgcn_s_getreg((3 << 11) | 20) & 0xFu; }
#define XB_SPIN(cond, bar) do { unsigned _sp = 0; while (cond) { __builtin_amdgcn_s_sleep(1); \
    if ((++_sp & 255u) == 0u) { if (xb_ld(&(bar)[XB_TMO])) break; if (_sp > XB_SPIN_CAP) { atomicAdd(&(bar)[XB_TMO], 1u); break; } } } } while (0)

struct XcdBarrier {
    unsigned* bar; unsigned x;
    volatile LAS unsigned* st;
};

__device__ __forceinline__ XcdBarrier xcd_barrier_post(unsigned* bar, volatile LAS unsigned* st) {
    XcdBarrier b; b.bar = bar; b.x = xb_xcc_id(); b.st = st;
    if (threadIdx.x == 0) (void)xb_add(&bar[XB_XCNT(b.x)], 1u);
    return b;
}
__device__ __forceinline__ void xcd_barrier_complete(unsigned* bar, unsigned x, unsigned& nloc, unsigned& nx) {
    const unsigned G = gridDim.x * gridDim.y * gridDim.z;
    unsigned sum, cnt, mine, sp = 0u;
    for (;;) {
        sum = 0u; cnt = 0u; mine = 0u;
#pragma unroll
        for (unsigned j = 0; j < 16; ++j) { const unsigned c = xb_ld(&bar[XB_XCNT(j)]); sum += c; cnt += (c > 0u) ? 1u : 0u; mine = (j == x) ? c : mine; }
        if (sum == G) break;
        __builtin_amdgcn_s_sleep(1);
        if ((++sp & 255u) == 0u) { if (xb_ld(&bar[XB_TMO])) break; if (sp > XB_SPIN_CAP) { atomicAdd(&bar[XB_TMO], 1u); break; } }
    }
    nloc = mine > 0u ? mine : 1u; nx = cnt > 0u ? cnt : 1u;
}

__device__ __forceinline__ void xcd_barrier(const XcdBarrier& b) {
    asm volatile("s_waitcnt vmcnt(0)" ::: "memory");
    __syncthreads();
    if (threadIdx.x == 0) {
        unsigned* bar = b.bar;
        __builtin_amdgcn_s_waitcnt(0);
        unsigned nloc = b.st[0], nx = b.st[1];
        if (nloc == 0u) { xcd_barrier_complete(bar, b.x, nloc, nx); b.st[0] = nloc; b.st[1] = nx; }
        const unsigned old = xb_add(&bar[XB_XSUB(b.x)], 1u);
        const unsigned gen = old / nloc;
        if (old + 1u == (gen + 1u) * nloc) {
            __builtin_amdgcn_fence(__ATOMIC_RELEASE, "agent");
            asm volatile("s_waitcnt vmcnt(0)" ::: "memory");
            const unsigned og = xb_add(&bar[XB_TOP], 1u);
            const unsigned tg = og / nx;
            if (og + 1u == (tg + 1u) * nx) xb_add(&bar[XB_TOPGEN], 1u);
            else XB_SPIN(xb_ld(&bar[XB_TOPGEN]) == tg, bar);
            __builtin_amdgcn_fence(__ATOMIC_ACQUIRE, "agent");
            xb_add(&bar[XB_XGEN(b.x)], 1u);
            asm volatile("s_waitcnt vmcnt(0)" ::: "memory");
        } else {
            XB_SPIN(xb_ld(&bar[XB_XGEN(b.x)]) == gen, bar);
            __builtin_amdgcn_fence(__ATOMIC_ACQUIRE, "agent");
            asm volatile("s_waitcnt vmcnt(0)" ::: "memory");
        }
    }
    __syncthreads();
}

struct Frame {
    LAS unsigned char* lds;
    volatile LAS unsigned* MISC;
    gu32* ctl;
    int tid, lane, wave;
    int vcu, G;
    const float* const* in; float* out; unsigned char* ws;
};
typedef float f32x16 __attribute__((ext_vector_type(16)));
typedef __bf16 bf16x2v __attribute__((ext_vector_type(2)));
typedef float f32x2 __attribute__((ext_vector_type(2)));
__device__ __forceinline__ unsigned pk2(float lo, float hi) { f32x2 v = {lo, hi}; bf16x2v b = __builtin_convertvector(v, bf16x2v); return __builtin_bit_cast(unsigned, b); }
__device__ __forceinline__ unsigned short f2bf1(float f) { return (unsigned short)(pk2(f, 0.f) & 0xffffu); }
__device__ __forceinline__ float bf2f(unsigned short b) { return __builtin_bit_cast(float, (unsigned)b << 16); }
__device__ __forceinline__ float fsigmoid(float x) { return __builtin_amdgcn_rcpf(1.0f + __expf(-x)); }
__device__ __forceinline__ float fsilu(float x) { return x * fsigmoid(x); }
__device__ __forceinline__ float wave_sum(float v) {
#pragma unroll
    for (int o = 1; o < 64; o <<= 1) v += __shfl_xor(v, o);
    return v;
}
template <int N> __device__ __forceinline__ float treduce(float (&v)[N], int lane) {
#pragma unroll
    for (int n = N / 2; n >= 1; n >>= 1) { const bool up = (lane & n) != 0;
#pragma unroll
        for (int i = 0; i < n; ++i) { const float a = v[i], b = v[i + n]; const float keep = up ? b : a, send = up ? a : b; v[i] = keep + __shfl_xor(send, n); } }
    float s = v[0];
#pragma unroll
    for (int m = N; m < 64; m <<= 1) s += __shfl_xor(s, m);
    return s;
}
__host__ __device__ __forceinline__ int kperm(int o) { const int q = (o >> 2) & 3; return (o & ~12) | ((q == 1 ? 2 : q == 2 ? 1 : q) << 2); }
enum { I_XP = 0, I_XS, I_SD, I_SQ, I_SC, I_META, I_F1N, I_F1W1, I_F1W3, I_F1W2, I_MIXN, I_WIN, I_QCW, I_ALOG, I_DTB, I_ONORM, I_CW, I_CB, I_CNORM, I_WOUT, I_F2N, I_F2W1, I_F2W3, I_F2W2, I_FINN };

__device__ __forceinline__ void p0_transpose_item(const float* W, int N, int K, int k0, int ncol0, int nvalid, const float* gain, bf16* WT, int drow0, LAS float* scr, int lane) {
    const int n = lane & 31;
#pragma unroll 8
    for (int i = 0; i < 32; ++i) { const int kk = 2 * i + (lane >> 5); float v = 0.f;
        if (n < nvalid) { v = W[(size_t)(k0 + kk) * N + ncol0 + n]; if (gain) v *= gain[k0 + kk]; }
        scr[kk * 33 + n] = v; }
    LDS_WAIT(); asm volatile("" ::: "memory");
    const int c = lane & 7;
#pragma unroll
    for (int j = 0; j < 4; ++j) { const int nn = (lane >> 3) + 8 * j; const LAS float* s = scr + (8 * c) * 33 + nn;
        v4u o; o.x = pk2(s[0 * 33], s[1 * 33]); o.y = pk2(s[2 * 33], s[3 * 33]); o.z = pk2(s[4 * 33], s[5 * 33]); o.w = pk2(s[6 * 33], s[7 * 33]);
        *(GAS v4u*)(WT + (size_t)(drow0 + nn) * K + k0 + 8 * c) = o; }
    LDS_WAIT(); asm volatile("" ::: "memory");
}
__device__ __forceinline__ const float* h0_row(const Frame& F, int row) {
    if (row < MPR) { const int b = row / LP, t = row - b * LP; return (t < 16) ? F.in[I_META] + t * D : F.in[I_XP] + ((size_t)b * 2048 + (t - 16)) * D; }
    if (row < MREAL) return F.in[I_XS] + (size_t)(row - MPR) * D;
    return nullptr;
}
__device__ __forceinline__ void p0_prologue(Frame& F) {
    LAS float* scr = (LAS float*)(F.lds + RING_OFF + F.wave * 16384);
    const int gw = F.vcu * NWAVES + F.wave, NGW = F.G * NWAVES;
    unsigned char* ws = F.ws;
    constexpr int I13 = 176 * 16, I2 = 32 * 44, IIN = 104 * 16, IOUT = 32 * 16;
    constexpr int NITEMS = 2 * I13 + 2 * I2 + IIN + IOUT;
    for (int it = gw; it < NITEMS; it += NGW) {
        int r = it;
        if (r < 2 * I13) {
            const int second = r >= I13; r -= second * I13; const int dg = r / 16, kb = r % 16, drow0 = 32 * dg, p = drow0 >> 8, w = drow0 & 255;
            const float* src = second ? (w >= 128 ? F.in[I_F2W3] : F.in[I_F2W1]) : (w >= 128 ? F.in[I_F1W3] : F.in[I_F1W1]); const float* gsrc = second ? F.in[I_F2N] : F.in[I_F1N];
            p0_transpose_item(src, DFF, D, 64 * kb, 128 * p + (w & 127), 32, gsrc, (bf16*)(ws + (second ? WS_W13B : WS_W13A)), drow0, scr, F.lane); continue; }
        r -= 2 * I13;
        if (r < 2 * I2) { const int second = r >= I2; r -= second * I2; const int dg = r / 44, kb = r % 44;
            p0_transpose_item(second ? F.in[I_F2W2] : F.in[I_F1W2], D, DFF, 64 * kb, 32 * dg, 32, nullptr, (bf16*)(ws + (second ? WS_W2B : WS_W2A)), 32 * dg, scr, F.lane); continue; }
        r -= 2 * I2;
        if (r < IIN) { const int dg = r / 16, kb = r % 16, drow0 = 32 * dg; int ncol0 = drow0, nvalid = 32;
            if (drow0 >= 3072) { ncol0 = 2048; nvalid = (drow0 == 3072) ? 8 : 0; }
            else if (drow0 >= 2048) { const int dd = drow0 - 2048, j = dd >> 8, w = dd & 255; ncol0 = (w < 128 ? 2056 : 2568) + 128 * j + (w & 127); }
            p0_transpose_item(F.in[I_WIN], NIN, D, 64 * kb, ncol0, nvalid, F.in[I_MIXN], (bf16*)(ws + WS_WIN), drow0, scr, F.lane); continue; }
        r -= IIN;
        { const int dg = r / 16, kb = r % 16; p0_transpose_item(F.in[I_WOUT], D, D, 64 * kb, 32 * dg, 32, nullptr, (bf16*)(ws + WS_WOUT), 32 * dg, scr, F.lane); }
    }
    bf16* UA = (bf16*)(ws + WS_UA); float* SSA = (float*)(ws + WS_SSA);
    for (int m = gw; m < MPAD; m += NGW) {
        const float* src = h0_row(F, m);
        f32x4 v[4]; float s = 0.f;
#pragma unroll
        for (int j = 0; j < 4; ++j) { v[j] = src ? ((const GAS f32x4*)src)[F.lane + 64 * j] : (f32x4){0.f, 0.f, 0.f, 0.f}; s += (v[j].x * v[j].x + v[j].y * v[j].y) + (v[j].z * v[j].z + v[j].w * v[j].w); }
        s = wave_sum(s);
        GAS unsigned long long* o8 = (GAS unsigned long long*)(UA + (size_t)m * D) + F.lane;
#pragma unroll
        for (int j = 0; j < 4; ++j) o8[64 * j] = (unsigned long long)pk2(v[j].x, v[j].y) | ((unsigned long long)pk2(v[j].z, v[j].w) << 32);
        if (F.lane < 16) SSA[(size_t)m * 16 + F.lane] = (F.lane == 0) ? s : 0.f;
    }
}

#define MFMA32(a, b, c) __builtin_amdgcn_mfma_f32_32x32x16_bf16((a), (b), (c), 0, 0, 0)
struct PrepUnit { int row0, ntok, prevkind, h; const float* sq; bf16 *NW, *QG, *KDT, *UT, *ATT; float* DL; };
template <int R> __device__ __forceinline__ void prep_unit(Frame& F, const PrepUnit& U, const bf16* QKV, const float* BA) {
    LAS unsigned char* L = F.lds;
    LAS float* AM = (LAS float*)(L + 34816);
    LAS float* sBeta = (LAS float*)(L + 51200); LAS float* sGc = (LAS float*)(L + 51456); LAS float* sEg = (LAS float*)(L + 51712); LAS float* sEk = (LAS float*)(L + 51968);
    LAS float* sPart = (LAS float*)(L + 52224); LAS float* sRs = (LAS float*)(L + 53248);
    const int tid = F.tid, lane = F.lane, wave = F.wave, role = wave >> 1, ch = tid & 127;
    float val[R];
    if (role < 3) {
        const int chan = (role == 0 ? 1024 : role == 1 ? 512 : 0) + U.h * 128 + ch;
        const float* cw = F.in[I_QCW];
        const float w0 = cw[chan], w1 = cw[1536 + chan], w2 = cw[3072 + chan], w3 = cw[4608 + chan];
        float xm3 = 0.f, xm2 = 0.f, xm1 = 0.f;
        if (U.prevkind == 1) { xm3 = bf2f(QKV[(size_t)(U.row0 - 3) * 1536 + chan]); xm2 = bf2f(QKV[(size_t)(U.row0 - 2) * 1536 + chan]); xm1 = bf2f(QKV[(size_t)(U.row0 - 1) * 1536 + chan]); }
        else if (U.prevkind == 2) { xm3 = U.sq[chan]; xm2 = U.sq[1536 + chan]; xm1 = U.sq[3072 + chan]; }
#pragma unroll
        for (int t = 0; t < R; ++t) {
            float xt = 0.f; if (t < U.ntok) xt = bf2f(QKV[(size_t)(U.row0 + t) * 1536 + chan]);
            const float y = w0 * xm3 + w1 * xm2 + w2 * xm1 + w3 * xt;
            val[t] = (t < U.ntok) ? fsilu(y) : 0.f;
            xm3 = xm2; xm2 = xm1; xm1 = xt;
        }
    } else {
#pragma unroll
        for (int t = 0; t < R; ++t) val[t] = 0.f;
        if (wave == 6) {
            float beta = 0.f, g = 0.f;
            if (lane < U.ntok) { const float* ba = BA + (size_t)(U.row0 + lane) * 8; beta = fsigmoid(ba[U.h]);
                const float x = ba[4 + U.h] + F.in[I_DTB][U.h]; const float sp = (x > 20.f) ? x : log1pf(__expf(x)); g = -__expf(F.in[I_ALOG][U.h]) * sp; }
            float gc = g;
#pragma unroll
            for (int d = 1; d < 64; d <<= 1) { const float o = __shfl_up(gc, d); if (lane >= d) gc += o; }
            const float glast = __shfl(gc, 63);
            sBeta[lane] = beta; sGc[lane] = gc; sEg[lane] = __expf(gc); sEk[lane] = __expf(glast - gc);
            if (lane == 0) *U.DL = __expf(glast);
        }
    }
    if (role == 1 || role == 2) {
        float sq[R];
#pragma unroll
        for (int t = 0; t < R; ++t) sq[t] = val[t] * val[t];
        const float mine = treduce<R>(sq, lane);
        if (lane < R) sPart[((role - 1) * 2 + (wave & 1)) * 64 + lane] = mine;
    }
    __syncthreads();
    if (tid < 128) { const int rr = tid >> 6, t = tid & 63; if (t < R) { const float s = sPart[(rr * 2) * 64 + t] + sPart[(rr * 2 + 1) * 64 + t];
        sRs[rr * 64 + t] = (1.0f / sqrtf(s + EPS)) * (rr ? 0.08838834764831845f : 1.0f); } }
    __syncthreads();
    if (role == 1 || role == 2) {
        LAS unsigned char* dst = L + (role == 1 ? 0 : 17408) + ch * 2;
#pragma unroll
        for (int t = 0; t < R; ++t) { val[t] *= sRs[(role - 1) * 64 + t]; *(LAS unsigned short*)(dst + t * 272) = f2bf1(val[t]); }
        if (R < 32) {
#pragma unroll
            for (int t = R; t < 32; ++t) *(LAS unsigned short*)(dst + t * 272) = (unsigned short)0;
        }
    }
    __syncthreads();
    float X[R];
    if (role < 2) {
#pragma unroll
        for (int i = 0; i < R; ++i) X[i] = (role == 0) ? sBeta[i] * val[i] : sBeta[i] * sEg[i] * val[i];
        if (role == 1) {
#pragma unroll
            for (int c8 = 0; c8 < R / 8; ++c8) { float e[8];
#pragma unroll
                for (int j = 0; j < 8; ++j) { const int c = kperm(8 * c8 + j); e[j] = val[c] * sEk[c]; }
                v4u o; o.x = pk2(e[0], e[1]); o.y = pk2(e[2], e[3]); o.z = pk2(e[4], e[5]); o.w = pk2(e[6], e[7]);
                *(GAS v4u*)(U.KDT + ch * R + 8 * c8) = o; }
        }
    } else {
#pragma unroll
        for (int i = 0; i < R; ++i) X[i] = 0.f;
        if (role == 2) { const int kp = kperm(ch);
#pragma unroll
            for (int c = 0; c < R; ++c) U.QG[c * 128 + kp] = f2bf1(val[c] * sEg[c]); }
    }
    {
        const int r = lane & 31, hh = lane >> 5;
        int kind = -1, ti = 0, tj = 0;
        if (R == 64) { if (wave < 6) { kind = wave / 3; const int q = wave % 3; ti = (q == 1) ? 0 : 1; tj = (q == 2) ? 1 : 0; } }
        else { if (wave == 1) kind = 0; else if (wave == 4) kind = 1; }
        if (kind >= 0) {
            const LAS unsigned char* Ab = L + (kind ? 17408 : 0) + (32 * ti + r) * 272 + hh * 16;
            const LAS unsigned char* Bb = L + (32 * tj + r) * 272 + hh * 16;
            f32x16 acc;
#pragma unroll
            for (int i = 0; i < 16; ++i) acc[i] = 0.f;
#pragma unroll
            for (int ks = 0; ks < 8; ++ks) { const bf16x8 a = *(const LAS bf16x8*)(Ab + ks * 32); const bf16x8 b = *(const LAS bf16x8*)(Bb + ks * 32); acc = MFMA32(a, b, acc); }
            const int col = 32 * tj + r; const float gcc = sGc[col];
#pragma unroll
            for (int i = 0; i < 16; ++i) { const int row = 32 * ti + (i & 3) + 8 * (i >> 2) + 4 * hh;
                const float e = (row >= col) ? __expf(sGc[row] - gcc) : 0.f;
                if (kind == 0) AM[row * 64 + col] = (row > col) ? sBeta[row] * acc[i] * e : 0.f;
                else if (row < R && col < R) U.ATT[row * R + kperm(col)] = f2bf1(acc[i] * e); }
        }
    }
    __syncthreads();
    if (role < 2) {
#pragma unroll
        for (int i = 1; i < R; ++i) { float a0 = 0.f, a1 = 0.f;
#pragma unroll
            for (int j = 0; j < i; ++j) { if (j & 1) a1 += AM[i * 64 + j] * X[j]; else a0 += AM[i * 64 + j] * X[j]; }
            X[i] -= (a0 + a1); }
        if (role == 0) {
#pragma unroll
            for (int c8 = 0; c8 < R / 8; ++c8) { v4u o; o.x = pk2(X[8 * c8], X[8 * c8 + 1]); o.y = pk2(X[8 * c8 + 2], X[8 * c8 + 3]); o.z = pk2(X[8 * c8 + 4], X[8 * c8 + 5]); o.w = pk2(X[8 * c8 + 6], X[8 * c8 + 7]);
                *(GAS v4u*)(U.UT + ch * R + 8 * c8) = o; }
        } else {
            const int kp = kperm(ch);
#pragma unroll
            for (int c = 0; c < R; ++c) U.NW[c * 128 + kp] = f2bf1(-X[c]);
        }
    }
    __syncthreads();
}
template <int NT> __device__ __forceinline__ void conv_job(Frame& F, int kind, int seq, int t0, const bf16* CIN, bf16* X3) {
    LAS float* tile = (LAS float*)F.lds;
    LAS float* sPart = (LAS float*)(F.lds + 126976);
    LAS float* sRstd = (LAS float*)(F.lds + 129024);
    const int ch = F.tid, lane = F.lane, wave = F.wave;
    const int rowbase = (kind == 0) ? seq * LP : MPR + seq * 8;
    for (int p = F.tid; p < (NT + 30) * 64; p += 512) { const int e = p >> 6, seg = p & 63, tp = t0 - 30 + e;
        f32x4 lo = {0.f, 0.f, 0.f, 0.f}, hi = {0.f, 0.f, 0.f, 0.f};
        if (tp >= 0) { const v4u q = *(const GAS v4u*)(CIN + (size_t)(rowbase + tp) * 512 + seg * 8);
            lo = (f32x4){__builtin_bit_cast(float, q.x << 16), __builtin_bit_cast(float, q.x & 0xffff0000u), __builtin_bit_cast(float, q.y << 16), __builtin_bit_cast(float, q.y & 0xffff0000u)};
            hi = (f32x4){__builtin_bit_cast(float, q.z << 16), __builtin_bit_cast(float, q.z & 0xffff0000u), __builtin_bit_cast(float, q.w << 16), __builtin_bit_cast(float, q.w & 0xffff0000u)}; }
        else if (kind == 1) { const GAS f32x4* sp = (const GAS f32x4*)(F.in[I_SC] + ((size_t)seq * 30 + (30 + tp)) * 512 + seg * 8); lo = sp[0]; hi = sp[1]; }
        *(LAS f32x4*)(tile + e * 512 + seg * 8) = lo; *(LAS f32x4*)(tile + e * 512 + seg * 8 + 4) = hi; }
    const float* cwp = F.in[I_CW];
    float w[31];
#pragma unroll
    for (int j = 0; j < 31; ++j) w[j] = cwp[j * 512 + ch];
    const float bias = F.in[I_CB][ch], gn = F.in[I_CNORM][ch];
    __syncthreads();
    float sq[NT];
#pragma unroll
    for (int g = 0; g < NT / 8; ++g) { float ext[38];
#pragma unroll
        for (int i = 0; i < 38; ++i) ext[i] = tile[(8 * g + i) * 512 + ch];
#pragma unroll
        for (int t = 0; t < 8; ++t) { float a = bias;
#pragma unroll
            for (int j = 0; j < 31; ++j) a += w[j] * ext[t + j];
            tile[(8 * g + t) * 512 + ch] = a; sq[8 * g + t] = a * a; } }
    const float mine = treduce<NT>(sq, lane);
    if (lane < NT) sPart[wave * 64 + lane] = mine;
    __syncthreads();
    if (F.tid < NT) { float s = 0.f;
#pragma unroll
        for (int wv = 0; wv < 8; ++wv) s += sPart[wv * 64 + F.tid];
        sRstd[F.tid] = 1.0f / sqrtf(s * (1.0f / 512.0f) + EPS); }
    __syncthreads();
#pragma unroll
    for (int t = 0; t < NT; ++t) { const float y = tile[t * 512 + ch] * sRstd[t] * gn; X3[(size_t)(rowbase + t0 + t) * 1024 + 512 + ch] = f2bf1(fsilu(y)); }
    __syncthreads();
}
__device__ __forceinline__ void p4_prep(Frame& F) {
    unsigned char* ws = F.ws;
    const bf16* QKV = (const bf16*)F.out; const float* BA = (const float*)(ws + WS_BA); const bf16* CIN = (const bf16*)(ws + WS_CIN); bf16* X3 = (bf16*)(ws + WS_UA);
    for (int f = F.vcu; f < 1024; f += F.G) {
        const int b = f >> 7, c1 = (f >> 2) & 31, h = f & 3;
        PrepUnit U; U.row0 = b * LP + 16 + 64 * c1; U.ntok = 64; U.prevkind = 1; U.h = h; U.sq = nullptr;
        U.NW = (bf16*)(ws + WS_NW) + (size_t)f * 8192; U.QG = (bf16*)(ws + WS_QG) + (size_t)f * 8192; U.KDT = (bf16*)(ws + WS_KDT) + (size_t)f * 8192; U.UT = (bf16*)(ws + WS_UT) + (size_t)f * 8192;
        U.ATT = (bf16*)(ws + WS_ATT) + (size_t)f * 4096; U.DL = (float*)(ws + WS_DL) + f;
        prep_unit<64>(F, U, QKV, BA);
    }
    for (int s = F.vcu; s < 544; s += F.G) {
        PrepUnit U; U.h = s & 3; unsigned char* base = ws + WS_SM + (size_t)s * SM_STRIDE;
        if (s < 32) { U.row0 = (s >> 2) * LP; U.ntok = 16; U.prevkind = 0; U.sq = nullptr; }
        else { const int sq = (s - 32) >> 2; U.row0 = MPR + sq * 8; U.ntok = 8; U.prevkind = 2; U.sq = F.in[I_SQ] + (size_t)sq * 3 * 1536; }
        U.NW = (bf16*)base; U.QG = (bf16*)(base + 4096); U.KDT = (bf16*)(base + 8192); U.UT = (bf16*)(base + 12288); U.ATT = (bf16*)(base + 16384); U.DL = (float*)(ws + WS_DL) + 1024 + s;
        prep_unit<16>(F, U, QKV, BA);
    }
    for (int j = F.vcu; j < 392; j += F.G) {
        if (j < 256) { conv_job<32>(F, 0, j >> 5, 64 * (j & 31), CIN, X3); conv_job<32>(F, 0, j >> 5, 64 * (j & 31) + 32, CIN, X3); }
        else if (j < 264) conv_job<16>(F, 0, j - 256, 2048, CIN, X3);
        else conv_job<8>(F, 1, j - 264, 0, CIN, X3);
    }
    float* out = F.out;
    const int gt = F.vcu * 512 + F.tid, NT = F.G * 512;
    for (int i = gt; i < 36864; i += NT) { const int c = i % 1536, r = i / 1536, b = r / 3, k = r % 3; out[OUT_QP + i] = bf2f(QKV[(size_t)(b * LP + 2061 + k) * 1536 + c]); }
    for (int i = gt; i < 122880; i += NT) { const int c = i & 511, r = i >> 9, b = r / 30, k = r % 30; out[OUT_CP + i] = bf2f(CIN[(size_t)(b * LP + 2034 + k) * 512 + c]); }
    for (int i = gt; i < 589824; i += NT) { const int c = i % 1536, r = i / 1536, s = r / 3, k = r % 3; out[OUT_QS + i] = bf2f(QKV[(size_t)(MPR + s * 8 + 5 + k) * 1536 + c]); }
    for (int i = gt; i < 1966080; i += NT) { const int c = i & 511, r = i >> 9, s = r / 30, k = r % 30;
        out[OUT_CS + i] = (k < 22) ? F.in[I_SC][((size_t)s * 30 + 8 + k) * 512 + c] : bf2f(CIN[(size_t)(MPR + s * 8 + (k - 22)) * 512 + c]); }
}

constexpr int SC_NW = 0, SC_QG = 17408, SC_ATT = 34816, SC_KDT = 44032, SC_UT = 62464, SC_RED = 79872, SC_RSTD = 80896, SC_IMG = 79872;
__device__ __forceinline__ bf16x8 pack8(const f32x16& x, int s) { v4u p; p.x = pk2(x[8 * s], x[8 * s + 1]); p.y = pk2(x[8 * s + 2], x[8 * s + 3]); p.z = pk2(x[8 * s + 4], x[8 * s + 5]); p.w = pk2(x[8 * s + 6], x[8 * s + 7]); return __builtin_bit_cast(bf16x8, p); }
__device__ __forceinline__ void scan_load(Frame& F, int R, const bf16* gNW, const bf16* gQG, const bf16* gATT, const bf16* gKDT, const bf16* gUT) {
    LAS unsigned char* L = F.lds; const int tid = F.tid;
    if (R < 64) { for (int p = tid; p < SC_IMG / 16; p += 512) *(LAS v4u*)(L + p * 16) = (v4u){0u, 0u, 0u, 0u}; __syncthreads(); }
    const int sh = (R == 64) ? 3 : 1;
    for (int p = tid; p < R * 16; p += 512) { const int row = p >> 4, seg = p & 15; *(LAS v4u*)(L + SC_NW + row * 272 + seg * 16) = ((const GAS v4u*)gNW)[p]; *(LAS v4u*)(L + SC_QG + row * 272 + seg * 16) = ((const GAS v4u*)gQG)[p]; }
    for (int p = tid; p < (R << sh); p += 512) { const int row = p >> sh, seg = p & ((1 << sh) - 1); *(LAS v4u*)(L + SC_ATT + row * 144 + seg * 16) = ((const GAS v4u*)gATT)[p]; }
    for (int p = tid; p < (128 << sh); p += 512) { const int row = p >> sh, seg = p & ((1 << sh) - 1); *(LAS v4u*)(L + SC_KDT + row * 144 + seg * 16) = ((const GAS v4u*)gKDT)[p]; }
    for (int p = tid; p < (128 << (sh + 1)); p += 512) { const int row = p >> (sh + 1), seg = p & ((2 << sh) - 1); *(LAS unsigned long long*)(L + SC_UT + row * 136 + seg * 8) = ((const GAS unsigned long long*)gUT)[p]; }
    __syncthreads();
}
__device__ __forceinline__ void scan_chain(Frame& F, int kind, int idx) {
    LAS unsigned char* L = F.lds; unsigned char* ws = F.ws;
    const int lane = F.lane, w = F.wave, r = lane & 31, hh = lane >> 5, h = idx & 3, sq = idx >> 2;
    const bf16* Z = (const bf16*)(ws + WS_Z); bf16* X3 = (bf16*)(ws + WS_UA);
    LAS float* RED = (LAS float*)(L + SC_RED); LAS float* RSTD = (LAS float*)(L + SC_RSTD);
    f32x16 S[4];
    const int dvc = 32 * (w & 3) + r;
    if (kind == 1 && w < 4) { const float* sp = F.in[I_SD] + ((size_t)sq * 4 + h) * 16384;
#pragma unroll
        for (int kb = 0; kb < 4; ++kb)
#pragma unroll
            for (int i = 0; i < 16; ++i) S[kb][i] = sp[(32 * kb + (i & 3) + 8 * (i >> 2) + 4 * hh) * 128 + dvc]; }
    else {
#pragma unroll
        for (int kb = 0; kb < 4; ++kb)
#pragma unroll
            for (int i = 0; i < 16; ++i) S[kb][i] = 0.f; }
    const float onorm = F.in[I_ONORM][dvc];
    const int nchunks = (kind == 0) ? 33 : 1;
    for (int ci = 0; ci < nchunks; ++ci) {
        int R, ntok, row0; const bf16 *gNW, *gQG, *gATT, *gKDT, *gUT; const float* gDL;
        if (kind == 0 && ci > 0) { const int f = sq * 128 + (ci - 1) * 4 + h; R = 64; ntok = 64; row0 = sq * LP + 16 + 64 * (ci - 1);
            gNW = (const bf16*)(ws + WS_NW) + (size_t)f * 8192; gQG = (const bf16*)(ws + WS_QG) + (size_t)f * 8192; gKDT = (const bf16*)(ws + WS_KDT) + (size_t)f * 8192; gUT = (const bf16*)(ws + WS_UT) + (size_t)f * 8192;
            gATT = (const bf16*)(ws + WS_ATT) + (size_t)f * 4096; gDL = (const float*)(ws + WS_DL) + f; }
        else { const int s = (kind == 0) ? idx : 32 + idx; const unsigned char* base = ws + WS_SM + (size_t)s * SM_STRIDE; R = 16;
            if (kind == 0) { ntok = 16; row0 = sq * LP; } else { ntok = 8; row0 = MPR + sq * 8; }
            gNW = (const bf16*)base; gQG = (const bf16*)(base + 4096); gKDT = (const bf16*)(base + 8192); gUT = (const bf16*)(base + 12288); gATT = (const bf16*)(base + 16384); gDL = (const float*)(ws + WS_DL) + 1024 + s; }
        __syncthreads();
        scan_load(F, R, gNW, gQG, gATT, gKDT, gUT);
        f32x16 o[2];
        if (w < 4) {
            const float dl = *gDL;
            f32x16 vn[2];
#pragma unroll
            for (int cb = 0; cb < 2; ++cb) {
#pragma unroll
                for (int i = 0; i < 16; ++i) o[cb][i] = 0.f;
#pragma unroll
                for (int q4 = 0; q4 < 4; ++q4) { const unsigned long long u8 = *(const LAS unsigned long long*)(L + SC_UT + dvc * 136 + (32 * cb + 8 * q4 + 4 * hh) * 2);
                    vn[cb][4 * q4 + 0] = bf2f((unsigned short)(u8 & 0xffffu)); vn[cb][4 * q4 + 1] = bf2f((unsigned short)((u8 >> 16) & 0xffffu));
                    vn[cb][4 * q4 + 2] = bf2f((unsigned short)((u8 >> 32) & 0xffffu)); vn[cb][4 * q4 + 3] = bf2f((unsigned short)(u8 >> 48)); } }
#pragma unroll
            for (int kb = 0; kb < 4; ++kb)
#pragma unroll
                for (int s = 0; s < 2; ++s) { const bf16x8 sb = pack8(S[kb], s);
#pragma unroll
                    for (int cb = 0; cb < 2; ++cb) {
                        const bf16x8 a = *(const LAS bf16x8*)(L + SC_NW + (32 * cb + r) * 272 + (kb * 2 + s) * 32 + hh * 16); vn[cb] = MFMA32(a, sb, vn[cb]);
                        const bf16x8 a2 = *(const LAS bf16x8*)(L + SC_QG + (32 * cb + r) * 272 + (kb * 2 + s) * 32 + hh * 16); o[cb] = MFMA32(a2, sb, o[cb]); } }
            bf16x8 vnb[2][2];
#pragma unroll
            for (int cb = 0; cb < 2; ++cb) { vnb[cb][0] = pack8(vn[cb], 0); vnb[cb][1] = pack8(vn[cb], 1); }
#pragma unroll
            for (int cb = 0; cb < 2; ++cb)
#pragma unroll
                for (int c2 = 0; c2 <= cb; ++c2)
#pragma unroll
                    for (int s = 0; s < 2; ++s) { const bf16x8 a = *(const LAS bf16x8*)(L + SC_ATT + (32 * cb + r) * 144 + (c2 * 2 + s) * 32 + hh * 16); o[cb] = MFMA32(a, vnb[c2][s], o[cb]); }
#pragma unroll
            for (int kb = 0; kb < 4; ++kb) {
#pragma unroll
                for (int i = 0; i < 16; ++i) S[kb][i] *= dl;
#pragma unroll
                for (int cb = 0; cb < 2; ++cb)
#pragma unroll
                    for (int s = 0; s < 2; ++s) { const bf16x8 a = *(const LAS bf16x8*)(L + SC_KDT + (32 * kb + r) * 144 + (cb * 2 + s) * 32 + hh * 16); S[kb] = MFMA32(a, vnb[cb][s], S[kb]); } }
#pragma unroll
            for (int cb = 0; cb < 2; ++cb)
#pragma unroll
                for (int i = 0; i < 16; ++i) { float s = o[cb][i] * o[cb][i];
                    s += __shfl_xor(s, 1); s += __shfl_xor(s, 2); s += __shfl_xor(s, 4); s += __shfl_xor(s, 8); s += __shfl_xor(s, 16);
                    if (r == 0) RED[w * 64 + 32 * cb + (i & 3) + 8 * (i >> 2) + 4 * hh] = s; }
        }
        __syncthreads();
        if (F.tid < 64) RSTD[F.tid] = 1.0f / sqrtf((RED[F.tid] + RED[64 + F.tid] + RED[128 + F.tid] + RED[192 + F.tid]) * (1.0f / 128.0f) + EPS);
        __syncthreads();
        if (w < 4) {
#pragma unroll
            for (int cb = 0; cb < 2; ++cb)
#pragma unroll
                for (int i = 0; i < 16; ++i) { const int c = 32 * cb + (i & 3) + 8 * (i >> 2) + 4 * hh;
                    if (c < ntok) { const size_t row = (size_t)(row0 + c); const float z = bf2f(Z[row * 512 + h * 128 + dvc]);
                        X3[row * 1024 + h * 128 + dvc] = f2bf1(o[cb][i] * RSTD[c] * onorm * fsilu(z)); } }
        }
    }
    if (w < 4) { float* dp = F.out + ((kind == 0) ? OUT_DP : OUT_DS) + ((size_t)sq * 4 + h) * 16384;
#pragma unroll
        for (int kb = 0; kb < 4; ++kb)
#pragma unroll
            for (int i = 0; i < 16; ++i) dp[(32 * kb + (i & 3) + 8 * (i >> 2) + 4 * hh) * 128 + dvc] = S[kb][i]; }
}
__device__ __forceinline__ void p5_scan(Frame& F) {
    if (F.vcu < 32) scan_chain(F, 0, F.vcu);
    else for (int u = F.vcu - 32; u < 512; u += F.G - 32) scan_chain(F, 1, u);
}
__device__ __forceinline__ void p9_final(Frame& F) {
    const int gw = F.vcu * NWAVES + F.wave, NGW = F.G * NWAVES;
    const float* H = (const float*)(F.ws + WS_H); const GAS f32x4* gn = (const GAS f32x4*)F.in[I_FINN];
    for (int m = gw; m < MREAL; m += NGW) {
        float* dst;
        if (m < MPR) { const int b = m / LP, t = m - b * LP; if (t < 16) continue; dst = F.out + OUT_YP + ((size_t)b * 2048 + (t - 16)) * D; }
        else dst = F.out + OUT_YS + (size_t)(m - MPR) * D;
        const GAS f32x4* src = (const GAS f32x4*)(H + (size_t)m * D);
        f32x4 v[4]; float s = 0.f;
#pragma unroll
        for (int j = 0; j < 4; ++j) { v[j] = src[F.lane + 64 * j]; s += (v[j].x * v[j].x + v[j].y * v[j].y) + (v[j].z * v[j].z + v[j].w * v[j].w); }
        const float rs = 1.0f / sqrtf(wave_sum(s) * (1.0f / D) + EPS);
#pragma unroll
        for (int j = 0; j < 4; ++j) ((GAS f32x4*)dst)[F.lane + 64 * j] = v[j] * rs * gn[F.lane + 64 * j];
    }
}

#ifndef MK_N_LAUNCHES
#define MK_N_LAUNCHES 1
#endif
constexpr int N_LAUNCHES = MK_N_LAUNCHES;
constexpr int NPHASES = 10;
template <class T> __device__ __forceinline__ T* sgpr_ptr(T* p) {
    const unsigned long long v = (unsigned long long)p; unsigned lo = __builtin_amdgcn_readfirstlane((unsigned)v), hi = __builtin_amdgcn_readfirstlane((unsigned)(v >> 32));
    asm volatile("" : "+s"(lo), "+s"(hi)); return (T*)(((unsigned long long)hi << 32) | lo);
}
struct Args { const float* in[25]; float* out; unsigned char* ws; int ph_lo, ph_hi, li, pad; };
__global__ void __launch_bounds__(NWAVES * 64, 2) mk_fwd(Args args) {
    extern __shared__ __attribute__((aligned(16))) unsigned char lds[];
    Frame F;
    F.lds = (LAS unsigned char*)lds;
    F.MISC = (volatile LAS unsigned*)(F.lds + MISC_OFF);
    F.tid = threadIdx.x; F.lane = F.tid & 63; F.wave = __builtin_amdgcn_readfirstlane(F.tid >> 6);
    F.G = gridDim.x; { const int bx = blockIdx.x; F.vcu = (F.G % 8 == 0) ? (bx % 8) * (F.G / 8) + bx / 8 : bx; }
    F.ws = nullptr; F.out = nullptr; F.in = nullptr; F.ctl = (gu32*)(args.ws + WS_CTL);
    for (int u = F.tid; u < (LDS_BYTES - LDSCTL_OFF) / 4; u += NWAVES * 64) ((LAS unsigned*)(F.lds + LDSCTL_OFF))[u] = 0u;
    __syncthreads();
    XcdBarrier bar; bar.bar = (unsigned*)(F.ctl + CW_BAR); bar.x = 0; bar.st = nullptr;
    if (N_LAUNCHES == 1) bar = xcd_barrier_post((unsigned*)(F.ctl + CW_BAR), F.MISC + 8);
    const int lo = args.ph_lo, hi = args.ph_hi;
#ifndef PHMASK
#define PHMASK 0x3ff
#endif
#define IN(k) (((PHMASK >> (k)) & 1) && lo <= (k) && (k) < hi)
#define SEAM(k) do { if (IN(k) && IN((k) + 1)) xcd_barrier(bar); } while (0)
#define PHASE_PTRS unsigned char* ws = sgpr_ptr(args.ws); float* outp = sgpr_ptr(args.out); const float* const* inp = args.in; \
    bf16* UA = (bf16*)(ws + WS_UA); bf16* HID = (bf16*)(ws + WS_HID); float* H = (float*)(ws + WS_H); float* SSA = (float*)(ws + WS_SSA); float* SSB = (float*)(ws + WS_SSB); \
    bf16* QKV = (bf16*)outp; bf16* U3 = (bf16*)outp; (void)UA; (void)HID; (void)H; (void)SSA; (void)SSB; (void)QKV; (void)U3; (void)inp;
#define PHASE_FRAME Frame Fp = F; { int t_ = threadIdx.x; asm volatile("" : "+v"(t_)); Fp.tid = t_; Fp.lane = t_ & 63; Fp.ws = ws; Fp.out = outp; Fp.in = inp; }

    if (IN(0)) { PHASE_PTRS PHASE_FRAME p0_prologue(Fp); } SEAM(0);
    if (IN(1)) { PHASE_PTRS
        pg8::Gemm g{UA, (const bf16*)(ws + WS_W13A), MPAD, 5632, D}; pg8::StaticOrder S; S.init(MPAD, 5632, F.G, (int)blockIdx.x);
        pg8::EpiSwiGLU E{HID, SSA};
        pg8::gemm_phase<pg8::EpiSwiGLU, pg8::StaticOrder, true, true>(F.lds + RING_OFF, g, S, E);
    } SEAM(1);
    if (IN(2)) { PHASE_PTRS
        pg8::Gemm g{HID, (const bf16*)(ws + WS_W2A), MPAD, D, DFF}; pg8::StaticOrder S; S.init(MPAD, D, F.G, (int)blockIdx.x);
        pg8::EpiResid E{H, UA, SSB, 0.5f, 1, inp[I_XP], inp[I_XS], inp[I_META]};
        pg8::gemm_phase<pg8::EpiResid, pg8::StaticOrder, true, true>(F.lds + RING_OFF, g, S, E);
    } SEAM(2);
    if (IN(3)) { PHASE_PTRS
        pg8::Gemm g{UA, (const bf16*)(ws + WS_WIN), MPAD, NINP, D}; pg8::StaticOrder S; S.init(MPAD, NINP, F.G, (int)blockIdx.x);
        pg8::EpiInProj E{QKV, (bf16*)(ws + WS_Z), (bf16*)(ws + WS_CIN), (float*)(ws + WS_BA), SSB};
        pg8::gemm_phase<pg8::EpiInProj, pg8::StaticOrder, true, true>(F.lds + RING_OFF, g, S, E);
    } SEAM(3);
    if (IN(4)) { PHASE_PTRS PHASE_FRAME p4_prep(Fp); } SEAM(4);
    if (IN(5)) { PHASE_PTRS PHASE_FRAME p5_scan(Fp); } SEAM(5);
    if (IN(6)) { PHASE_PTRS
        pg8::Gemm g{UA, (const bf16*)(ws + WS_WOUT), MPAD, D, D}; pg8::StaticOrder S; S.init(MPAD, D, F.G, (int)blockIdx.x);
        pg8::EpiResid E{H, U3, SSA, 1.0f, 0, nullptr, nullptr, nullptr};
        pg8::gemm_phase<pg8::EpiResid, pg8::StaticOrder, true, true>(F.lds + RING_OFF, g, S, E);
    } SEAM(6);
    if (IN(7)) { PHASE_PTRS
        pg8::Gemm g{U3, (const bf16*)(ws + WS_W13B), MPAD, 5632, D}; pg8::StaticOrder S; S.init(MPAD, 5632, F.G, (int)blockIdx.x);
        pg8::EpiSwiGLU E{HID, SSA};
        pg8::gemm_phase<pg8::EpiSwiGLU, pg8::StaticOrder, true, true>(F.lds + RING_OFF, g, S, E);
    } SEAM(7);
    if (IN(8)) { PHASE_PTRS
        pg8::Gemm g{HID, (const bf16*)(ws + WS_W2B), MPAD, D, DFF}; pg8::StaticOrder S; S.init(MPAD, D, F.G, (int)blockIdx.x);
        pg8::EpiResid E{H, nullptr, nullptr, 0.5f, 0, nullptr, nullptr, nullptr};
        pg8::gemm_phase<pg8::EpiResid, pg8::StaticOrder, true, true>(F.lds + RING_OFF, g, S, E);
    } SEAM(8);
    if (IN(9)) { PHASE_PTRS PHASE_FRAME p9_final(Fp); }
#undef IN
#undef SEAM
}

extern "C" void kernel_launch(void* const* d_in, const int* in_sizes, int n_in, void* d_out, int out_size, void* d_ws, size_t ws_size, hipStream_t stream) {
    static int grid = 0;
    if (grid == 0) {
        if (n_in != 25 || out_size != (int)OUT_TOTAL || ws_size < WS_END) { fprintf(stderr, "kernel_launch: unexpected shapes (n_in %d, out %d, ws %zu); nothing launched\n", n_in, out_size, ws_size); grid = -1; return; }
        int dev = 0, cus = 0, per_cu = 0;
        if (hipGetDevice(&dev) != hipSuccess || hipDeviceGetAttribute(&cus, hipDeviceAttributeMultiprocessorCount, dev) != hipSuccess) { grid = -1; return; }
        if (hipFuncSetAttribute((const void*)mk_fwd, hipFuncAttributeMaxDynamicSharedMemorySize, LDS_BYTES) != hipSuccess) { fprintf(stderr, "kernel_launch: hipFuncSetAttribute failed\n"); grid = -1; return; }
        if (hipOccupancyMaxActiveBlocksPerMultiprocessor(&per_cu, (const void*)mk_fwd, NWAVES * 64, LDS_BYTES) != hipSuccess || per_cu < 1)
            fprintf(stderr, "kernel_launch: note: occupancy query reports %d workgroups per CU\n", per_cu);
        (void)hipGetLastError();
        grid = cus;
    }
    if (grid < 0) return;
    if (hipMemsetAsync((char*)d_ws + WS_CTL, 0, CTL_ZERO_BYTES, stream) != hipSuccess) { fprintf(stderr, "kernel_launch: hipMemsetAsync failed\n"); return; }
    Args a{};
    for (int i = 0; i < 25; ++i) a.in[i] = (const float*)d_in[i];
    a.out = (float*)d_out; a.ws = (unsigned char*)d_ws;
    for (int li = 0; li < N_LAUNCHES; ++li) {
        a.ph_lo = (N_LAUNCHES == 1) ? 0 : li; a.ph_hi = (N_LAUNCHES == 1) ? NPHASES : li + 1; a.li = li;
        hipLaunchKernelGGL(mk_fwd, dim3(grid), dim3(NWAVES * 64), LDS_BYTES, stream, a);
        const hipError_t le = hipPeekAtLastError();
        if (le != hipSuccess) { fprintf(stderr, "kernel_launch: launch %d failed: %s\n", li, hipGetErrorName(le)); break; }
    }
}
```

```cpp
#include <hip/hip_runtime.h>
#include <cstdio>
#include <cstdint>
namespace pg8 {
#define PG8_LAS __attribute__((address_space(3)))
typedef unsigned short bf16_t;
typedef short bf16x8 __attribute__((ext_vector_type(8)));
typedef float f32x4 __attribute__((ext_vector_type(4)));
typedef unsigned u32x4 __attribute__((ext_vector_type(4)));
constexpr int BM = 256, BK = 64, HALF = 128, HTB = HALF * BK * 2  , STAGE_BYTES = 8 * HTB, NXCD = 8, WGM = 8;

__host__ __device__ __forceinline__ int lds_byte(int r, int c) { const int st = (r >> 4) * 2 + (c >> 5), rr = r & 15, cc = c & 31, ob = rr * 64 + cc * 2; return st * 1024 + (ob ^ (((ob >> 9) & 1) << 5)); }
__host__ __device__ __forceinline__ void stage_rc(int b, int& R, int& C) { const int st = b / 1024, sb = b % 1024, swz = sb ^ (((sb >> 9) & 1) << 5); R = (st >> 1) * 16 + swz / 64; C = (st & 1) * 32 + (swz % 64) / 2; }
__host__ __device__ __forceinline__ int perm32(int rho) { const int n = rho >> 4, i = rho & 15; return 8 * (i >> 2) + 4 * n + (i & 3); }

struct Unit { int pm, pn; };
struct Gemm { const bf16_t* A; const bf16_t* Bt; int M, N, K; };

struct StaticOrder {
    int nM, nN, nwg, G, c;
    __host__ __device__ void init(int M, int N, int G_, int c_) { nM = M / BM; nN = N / BM; nwg = nM * nN; G = G_; c = c_; }
    __host__ __device__ bool next(int i, Unit& u) const {
        const long L = (long)i * G + c; if (L >= nwg) return false;
        int wgid = (int)L; { const int q = nwg / NXCD, r = nwg % NXCD, xcd = wgid % NXCD, off = wgid / NXCD; wgid = (xcd < r ? xcd * (q + 1) : r * (q + 1) + (xcd - r) * q) + off; }
        const int nig = WGM * nN, gid = wgid / nig, fm = gid * WGM, gsz = (nM - fm) < WGM ? (nM - fm) : WGM;
        u.pm = fm + ((wgid % nig) % gsz); u.pn = (wgid % nig) / gsz; return true;
    }
    __device__ __forceinline__ void a_ready(const Unit&) const {}
    __device__ __forceinline__ void done(const Unit&) const {}
};

typedef float f32x2 __attribute__((ext_vector_type(2)));
typedef __bf16 bf16x2v __attribute__((ext_vector_type(2)));
__device__ __forceinline__ unsigned pk2(float lo, float hi) { f32x2 v = {lo, hi}; bf16x2v b = __builtin_convertvector(v, bf16x2v); return __builtin_bit_cast(unsigned, b); }
__device__ __forceinline__ float fsigmoid(float x) { return __builtin_amdgcn_rcpf(1.0f + __expf(-x)); }
__device__ __forceinline__ float fsilu(float x) { return x * fsigmoid(x); }
__device__ __forceinline__ float row_rstd(const float* ss, int row) {
    const f32x4* p = (const f32x4*)(ss + (size_t)row * 16);
    const f32x4 a = p[0], b = p[1], c = p[2], d = p[3];
    const float s = (((a[0] + a[1]) + (a[2] + a[3])) + ((b[0] + b[1]) + (b[2] + b[3]))) + (((c[0] + c[1]) + (c[2] + c[3])) + ((d[0] + d[1]) + (d[2] + d[3])));
    return 1.0f / sqrtf(s * (1.0f / 1024.0f) + 1e-6f);
}
struct EpiSwiGLU {
    static constexpr bool PERM = true, AFTER_DRAIN = false;
    bf16_t* O; const float* ss;
    __device__ __forceinline__ void operator()(const f32x4 (&acc)[2][2][4][2], const Unit& u, int wr, int wc, int fr, int fq) const {
        const int row0 = u.pm * BM + wr * 64 + fr, col0 = u.pn * 128 + wc * 32 + 8 * fq;
#pragma unroll
        for (int ai = 0; ai < 2; ++ai)
#pragma unroll
            for (int m = 0; m < 4; ++m) { const int row = row0 + ai * HALF + m * 16; const float rs = row_rstd(ss, row);
                const f32x4 g0 = acc[ai][0][m][0] * rs, g1 = acc[ai][0][m][1] * rs, u0 = acc[ai][1][m][0] * rs, u1 = acc[ai][1][m][1] * rs;
                u32x4 w; w.x = pk2(fsilu(g0[0]) * u0[0], fsilu(g0[1]) * u0[1]); w.y = pk2(fsilu(g0[2]) * u0[2], fsilu(g0[3]) * u0[3]);
                w.z = pk2(fsilu(g1[0]) * u1[0], fsilu(g1[1]) * u1[1]); w.w = pk2(fsilu(g1[2]) * u1[2], fsilu(g1[3]) * u1[3]);
                *(u32x4*)(O + (size_t)row * 2816 + col0) = w; }
    }
};
struct EpiInProj {
    static constexpr bool PERM = true, AFTER_DRAIN = false;
    bf16_t* QKV; bf16_t* Z; bf16_t* CIN; float* BA; const float* ss;
    __device__ __forceinline__ void operator()(const f32x4 (&acc)[2][2][4][2], const Unit& u, int wr, int wc, int fr, int fq) const {
        const int row0 = u.pm * BM + wr * 64 + fr, cw = wc * 32 + 8 * fq;
#pragma unroll
        for (int ai = 0; ai < 2; ++ai)
#pragma unroll
            for (int m = 0; m < 4; ++m) { const int row = row0 + ai * HALF + m * 16; const float rs = row_rstd(ss, row);
                if (u.pn < 8) {
                    bf16_t* rowp = (u.pn < 6) ? QKV + (size_t)row * 1536 + u.pn * 256 + cw : Z + (size_t)row * 512 + (u.pn - 6) * 256 + cw;
#pragma unroll
                    for (int bj = 0; bj < 2; ++bj) { const f32x4 v0 = acc[ai][bj][m][0] * rs, v1 = acc[ai][bj][m][1] * rs;
                        u32x4 w; w.x = pk2(v0[0], v0[1]); w.y = pk2(v0[2], v0[3]); w.z = pk2(v1[0], v1[1]); w.w = pk2(v1[2], v1[3]);
                        *(u32x4*)(rowp + bj * HALF) = w; }
                } else if (u.pn < 12) {
                    const f32x4 a0 = acc[ai][0][m][0] * rs, a1 = acc[ai][0][m][1] * rs, g0 = acc[ai][1][m][0] * rs, g1 = acc[ai][1][m][1] * rs;
                    u32x4 w; w.x = pk2(a0[0] * fsigmoid(g0[0]), a0[1] * fsigmoid(g0[1])); w.y = pk2(a0[2] * fsigmoid(g0[2]), a0[3] * fsigmoid(g0[3]));
                    w.z = pk2(a1[0] * fsigmoid(g1[0]), a1[1] * fsigmoid(g1[1])); w.w = pk2(a1[2] * fsigmoid(g1[2]), a1[3] * fsigmoid(g1[3]));
                    *(u32x4*)(CIN + (size_t)row * 512 + (u.pn - 8) * 128 + cw) = w;
                } else if (wc == 0 && fq == 0) {
                    *(f32x4*)(BA + (size_t)row * 8) = acc[ai][0][m][0] * rs; *(f32x4*)(BA + (size_t)row * 8 + 4) = acc[ai][0][m][1] * rs;
                }
            }
    }
};
struct EpiResid {
    static constexpr bool PERM = false, AFTER_DRAIN = false;
    float* H; bf16_t* U; float* SS; float scale; int h0; const float* xp; const float* xs; const float* meta;
    __device__ __forceinline__ void operator()(const f32x4 (&acc)[2][2][4][2], const Unit& u, int wr, int wc, int fr, int fq) const {
        const int row0 = u.pm * BM + wr * 64 + fr, col0 = u.pn * BM + wc * 32 + 4 * fq;
#pragma unroll
        for (int ai = 0; ai < 2; ++ai)
#pragma unroll
            for (int m = 0; m < 4; ++m) { const int row = row0 + ai * HALF + m * 16;
                const float* rp = H + (size_t)row * 1024;
                if (h0) { if (row < 16512) { const int b = row / 2064, t = row - b * 2064; rp = (t < 16) ? meta + t * 1024 : xp + ((size_t)b * 2048 + (t - 16)) * 1024; }
                          else if (row < 17536) rp = xs + (size_t)(row - 16512) * 1024; else rp = nullptr; }
                float s = 0.f;
#pragma unroll
                for (int bj = 0; bj < 2; ++bj)
#pragma unroll
                    for (int n = 0; n < 2; ++n) { const int c = col0 + bj * HALF + n * 16;
                        const f32x4 r = rp ? *(const f32x4*)(rp + c) : (f32x4){0.f, 0.f, 0.f, 0.f};
                        const f32x4 v = r + acc[ai][bj][m][n] * scale;
                        *(f32x4*)(H + (size_t)row * 1024 + c) = v;
                        s += (v[0] * v[0] + v[1] * v[1]) + (v[2] * v[2] + v[3] * v[3]);
                        if (U) { unsigned long long w = (unsigned long long)pk2(v[0], v[1]) | ((unsigned long long)pk2(v[2], v[3]) << 32); *(unsigned long long*)(U + (size_t)row * 1024 + c) = w; } }
                if (SS) { s += __shfl_xor(s, 16); s += __shfl_xor(s, 32); if (fq == 0) SS[(size_t)row * 16 + u.pn * 4 + wc] = s; }
            }
    }
};

template <class Epi, class Sched, bool ALIGN_EPI = false, bool SP2 = false>
__device__ __forceinline__ void gemm_phase(PG8_LAS unsigned char* lds, const Gemm g, const Sched& S, const Epi& E) {
    const int tid = threadIdx.x, wid = __builtin_amdgcn_readfirstlane(tid >> 6), lane = tid & 63, wr = wid >> 2, wc = wid & 3, fr = lane & 15, fq = lane >> 4;
    const int K = g.K, nt = K / BK;
    unsigned voffA[2], voffB[2];
#pragma unroll
    for (int i = 0; i < 2; ++i) { int R, C; stage_rc(tid * 16 + i * 8192, R, C); const int Rb = Epi::PERM ? ((R & ~31) + perm32(R & 31)) : R;
        voffA[i] = (unsigned)(R * K + C) * 2u; voffB[i] = (unsigned)(Rb * K + C) * 2u; }
    const size_t kstep = (size_t)(BK * 2);
    const size_t hstep = (size_t)HALF * K * 2;
    const size_t tstep = 2 * hstep;
    const unsigned ldsw = (unsigned)wid * 1024u;
    const int aoff = lds_byte(wr * 64 + fr, fq * 8), boff = lds_byte(wc * 32 + fr, fq * 8);
#define PG8_SA(b, h) (((b) * 2 + (h)) * HTB)
#define PG8_SB(b, h) ((4 + (b) * 2 + (h)) * HTB)
#define PG8_STAGE(bufoff, gbase, voff) do { _Pragma("unroll") for (int _i = 0; _i < 2; ++_i) \
        __builtin_amdgcn_global_load_lds((const unsigned*)((const char*)(gbase) + (voff)[_i]), (PG8_LAS unsigned*)(lds + (bufoff) + ldsw + _i * 8192), 16, 0, 0); } while (0)
#define PG8_LDA(dst, b, h) do { _Pragma("unroll") for (int m = 0; m < 4; ++m) _Pragma("unroll") for (int k = 0; k < 2; ++k) dst[m][k] = *(const PG8_LAS bf16x8*)(lds + PG8_SA(b, h) + aoff + m * 2048 + k * 1024); } while (0)
#define PG8_LDB(dst, b, h) do { _Pragma("unroll") for (int n = 0; n < 2; ++n) _Pragma("unroll") for (int k = 0; k < 2; ++k) dst[n][k] = *(const PG8_LAS bf16x8*)(lds + PG8_SB(b, h) + boff + n * 2048 + k * 1024); } while (0)
#define PG8_MMA(ai, bj, At, Bt) do { __builtin_amdgcn_s_setprio(1); _Pragma("unroll") for (int m = 0; m < 4; ++m) _Pragma("unroll") for (int n = 0; n < 2; ++n) _Pragma("unroll") for (int k = 0; k < 2; ++k) \
        acc[ai][bj][m][n] = __builtin_amdgcn_mfma_f32_16x16x32_bf16(Bt[n][k], At[m][k], acc[ai][bj][m][n], 0, 0, 0); __builtin_amdgcn_s_setprio(0); } while (0)
#define PG8_WAIT_V(n) asm volatile("s_waitcnt vmcnt(" #n ")" ::: "memory")
#define PG8_WAIT_L(n) asm volatile("s_waitcnt lgkmcnt(" #n ")" ::: "memory")
#define PG8_BAR __builtin_amdgcn_s_barrier()
#define PG8_SCHED __builtin_amdgcn_sched_barrier(0)
    Unit cur, nxt; int ui = 0;
    if (!S.next(0, cur)) return;
    f32x4 acc[2][2][4][2];
#pragma unroll
    for (int a = 0; a < 2; ++a)
#pragma unroll
        for (int b = 0; b < 2; ++b)
#pragma unroll
            for (int m = 0; m < 4; ++m)
#pragma unroll
                for (int n = 0; n < 2; ++n) acc[a][b][m][n] = (f32x4){0.f, 0.f, 0.f, 0.f};
    bf16x8 At[4][2], B0[2][2], B1[2][2];
    const char* cA = (const char*)g.A + (size_t)cur.pm * tstep; const char* cB = (const char*)g.Bt + (size_t)cur.pn * tstep;
    S.a_ready(cur);
    if constexpr (SP2) {
        PG8_STAGE(PG8_SB(0, 0), cB, voffB); PG8_STAGE(PG8_SB(0, 1), cB + hstep, voffB); PG8_STAGE(PG8_SA(0, 0), cA, voffA); PG8_STAGE(PG8_SA(0, 1), cA + hstep, voffA);
        if (wr == 1) PG8_BAR;
        PG8_WAIT_V(2); PG8_BAR;
        PG8_STAGE(PG8_SB(1, 0), cB + kstep, voffB); PG8_STAGE(PG8_SA(1, 0), cA + kstep, voffA); PG8_STAGE(PG8_SB(1, 1), cB + hstep + kstep, voffB);
        PG8_WAIT_V(6); PG8_BAR;
    } else {
        PG8_STAGE(PG8_SB(0, 0), cB, voffB); PG8_STAGE(PG8_SA(0, 0), cA, voffA); PG8_STAGE(PG8_SB(0, 1), cB + hstep, voffB); PG8_STAGE(PG8_SA(0, 1), cA + hstep, voffA);
        if (wr == 1) PG8_BAR;
        PG8_WAIT_V(4); PG8_BAR;
        PG8_STAGE(PG8_SB(1, 0), cB + kstep, voffB); PG8_STAGE(PG8_SA(1, 0), cA + kstep, voffA); PG8_STAGE(PG8_SB(1, 1), cB + hstep + kstep, voffB);
        PG8_WAIT_V(6); PG8_BAR;
    }
    for (;;) {
        const bool has_next = S.next(ui + 1, nxt);
        const char* nA = has_next ? (const char*)g.A + (size_t)nxt.pm * tstep : cA; const char* nB = has_next ? (const char*)g.Bt + (size_t)nxt.pn * tstep : cB;
        for (int t = 0; t < nt; t += 2) {
            const bool last = (t == nt - 2);
            const char* a1 = cA + (size_t)(t + 1) * kstep;
            const char* a2 = last ? nA : cA + (size_t)(t + 2) * kstep; const char* b2 = last ? nB : cB + (size_t)(t + 2) * kstep;
            const char* a3 = a2 + kstep; const char* b3 = b2 + kstep;
            if (last && has_next) S.a_ready(nxt);
            if constexpr (SP2) {
            PG8_LDB(B0, 0, 0); PG8_LDB(B1, 0, 1); PG8_SCHED; PG8_LDA(At, 0, 0); PG8_STAGE(PG8_SA(1, 1), a1 + hstep, voffA);
            PG8_WAIT_V(8); PG8_WAIT_L(0); PG8_BAR; PG8_MMA(0, 0, At, B0); PG8_MMA(0, 1, At, B1); PG8_BAR; PG8_SCHED;
            PG8_LDA(At, 0, 1); PG8_STAGE(PG8_SB(0, 0), b2, voffB); PG8_STAGE(PG8_SB(0, 1), b2 + hstep, voffB); PG8_STAGE(PG8_SA(0, 0), a2, voffA);
            PG8_WAIT_V(8); PG8_WAIT_L(0); PG8_BAR; PG8_MMA(1, 0, At, B0); PG8_MMA(1, 1, At, B1); PG8_BAR; PG8_SCHED;
            PG8_LDB(B0, 1, 0); PG8_LDB(B1, 1, 1); PG8_SCHED; PG8_LDA(At, 1, 0); PG8_STAGE(PG8_SA(0, 1), a2 + hstep, voffA);
            PG8_WAIT_V(8); PG8_WAIT_L(0); PG8_BAR; PG8_MMA(0, 0, At, B0); PG8_MMA(0, 1, At, B1); PG8_BAR; PG8_SCHED;
            PG8_LDA(At, 1, 1); PG8_STAGE(PG8_SB(1, 0), b3, voffB); PG8_STAGE(PG8_SB(1, 1), b3 + hstep, voffB); PG8_STAGE(PG8_SA(1, 0), a3, voffA);
            PG8_WAIT_V(8); PG8_WAIT_L(0); PG8_BAR; PG8_MMA(1, 0, At, B0); PG8_MMA(1, 1, At, B1); PG8_BAR; PG8_SCHED;
            } else {
            PG8_LDB(B0, 0, 0); PG8_SCHED; PG8_LDA(At, 0, 0); PG8_STAGE(PG8_SA(1, 1), a1 + hstep, voffA);
            PG8_WAIT_L(8); PG8_BAR; PG8_WAIT_L(0); PG8_MMA(0, 0, At, B0); PG8_BAR; PG8_SCHED;
            PG8_LDB(B1, 0, 1); PG8_STAGE(PG8_SB(0, 0), b2, voffB);
            PG8_BAR; PG8_WAIT_L(0); PG8_MMA(0, 1, At, B1); PG8_BAR;
            PG8_LDA(At, 0, 1); PG8_STAGE(PG8_SA(0, 0), a2, voffA);
            PG8_BAR; PG8_WAIT_L(0); PG8_MMA(1, 0, At, B0); PG8_BAR; PG8_SCHED;
            PG8_STAGE(PG8_SB(0, 1), b2 + hstep, voffB);
            PG8_WAIT_V(6); PG8_BAR; PG8_MMA(1, 1, At, B1); PG8_BAR;
            PG8_LDB(B0, 1, 0); PG8_SCHED; PG8_LDA(At, 1, 0); PG8_STAGE(PG8_SA(0, 1), a2 + hstep, voffA);
            PG8_WAIT_L(8); PG8_BAR; PG8_WAIT_L(0); PG8_MMA(0, 0, At, B0); PG8_BAR; PG8_SCHED;
            PG8_LDB(B1, 1, 1); PG8_STAGE(PG8_SB(1, 0), b3, voffB);
            PG8_BAR; PG8_WAIT_L(0); PG8_MMA(0, 1, At, B1); PG8_BAR;
            PG8_LDA(At, 1, 1); PG8_STAGE(PG8_SA(1, 0), a3, voffA);
            PG8_BAR; PG8_WAIT_L(0); PG8_MMA(1, 0, At, B0); PG8_BAR; PG8_SCHED;
            PG8_STAGE(PG8_SB(1, 1), b3 + hstep, voffB);
            PG8_WAIT_V(6); PG8_BAR; PG8_MMA(1, 1, At, B1); PG8_BAR;
            }
        }
        if constexpr (ALIGN_EPI) { if (wr == 0) PG8_BAR; }
        if constexpr (!Epi::AFTER_DRAIN) { E(acc, cur, wr, wc, fr, fq); S.done(cur); }
        if (!has_next) break;
#pragma unroll
        for (int a = 0; a < 2; ++a)
#pragma unroll
            for (int b = 0; b < 2; ++b)
#pragma unroll
                for (int m = 0; m < 4; ++m)
#pragma unroll
                    for (int n = 0; n < 2; ++n) acc[a][b][m][n] = (f32x4){0.f, 0.f, 0.f, 0.f};
        cur = nxt; cA = nA; cB = nB; ++ui;
        if constexpr (ALIGN_EPI) { if (wr == 1) PG8_BAR; }
    }
    PG8_WAIT_V(0);
    if constexpr (!ALIGN_EPI) { if (wr == 0) PG8_BAR; }
    PG8_BAR;
    if constexpr (Epi::AFTER_DRAIN) { E.fused(acc, cur, wr, wc, fr, fq, lds, wid, lane); S.done(cur); }
#undef PG8_SA
#undef PG8_SB
#undef PG8_STAGE
#undef PG8_LDA
#undef PG8_LDB
#undef PG8_MMA
#undef PG8_WAIT_V
#undef PG8_WAIT_L
#undef PG8_BAR
#undef PG8_SCHED
}
}

constexpr int NWAVES = 8;
constexpr int D = 1024, DFF = 2816, LP = 2064, MPR = 8 * LP  , MREAL = MPR + 1024  , MPAD = 17664  ;
constexpr int NIN = 3080, NINP = 3328;
constexpr float EPS = 1e-6f;
constexpr size_t MiB = 1u << 20;
constexpr size_t WS_CTL = 0, CTL_ZERO_BYTES = 1 * MiB;
constexpr size_t WS_W13A = 1 * MiB, WS_W2A = 12 * MiB, WS_WIN = 17 * MiB + MiB / 2, WS_WOUT = 24 * MiB, WS_W13B = 26 * MiB, WS_W2B = 37 * MiB;
constexpr size_t WS_BA = 42 * MiB + MiB / 2;
constexpr size_t WS_H = 44 * MiB;
constexpr size_t WS_UA = 113 * MiB;
constexpr size_t WS_HID = 147 * MiB + MiB / 2;
constexpr size_t WS_Z = WS_HID, WS_CIN = WS_Z + (size_t)MPAD * 512 * 2;
constexpr size_t WS_NW = 182 * MiB, WS_QG = 198 * MiB, WS_KDT = 214 * MiB, WS_UT = 230 * MiB;
constexpr size_t WS_SSA = 246 * MiB, WS_SSB = 247 * MiB + MiB / 4;
constexpr size_t WS_DL = 248 * MiB + MiB / 2;
constexpr size_t WS_ATT = 1 * MiB;
constexpr size_t WS_SM = 9 * MiB + MiB / 4;
constexpr size_t SM_STRIDE = 16896, WS_END = 256 * MiB;
static_assert(WS_W2A - WS_W13A == (size_t)5632 * 1024 * 2 && WS_WIN - WS_W2A == (size_t)1024 * 2816 * 2 && WS_WOUT - WS_WIN == (size_t)NINP * 1024 * 2 && WS_W13B - WS_WOUT == (size_t)1024 * 1024 * 2 && WS_W2B - WS_W13B == (size_t)5632 * 1024 * 2 && WS_W2B + (size_t)1024 * 2816 * 2 <= WS_BA, "weights map");
static_assert(WS_BA + (size_t)MPAD * 8 * 4 <= WS_H && WS_H + (size_t)MPAD * 1024 * 4 == WS_UA && WS_UA + (size_t)MPAD * 1024 * 2 == WS_HID && WS_HID + (size_t)MPAD * 2816 * 2 <= WS_SSA, "activation map");
static_assert(WS_CIN + (size_t)MPAD * 512 * 2 <= WS_NW && WS_UT + 16 * MiB <= WS_SSA && WS_SSA + (size_t)MPAD * 64 <= WS_SSB && WS_SSB + (size_t)MPAD * 64 <= WS_DL && WS_DL + 2048 * 4 <= WS_END, "mixer overlay map");
static_assert(WS_ATT + 1024 * 8192 <= WS_SM && WS_SM + 544 * SM_STRIDE <= WS_WOUT, "scan small-unit map");
constexpr size_t OUT_YP = 0, OUT_YS = 16777216, OUT_DP = 17825792, OUT_QP = 18350080, OUT_CP = 18386944, OUT_DS = 18509824, OUT_QS = 26898432, OUT_CS = 27488256, OUT_TOTAL = 29454336;
static_assert((size_t)MPAD * 1536 * 2 <= OUT_YS * 4, "QKV scratch fits the y_prompt range");
constexpr int CW_BAR = 4096;
constexpr int RING_OFF = 0, RING_BYTES = 131072;
constexpr int LDSCTL_OFF = RING_BYTES, MISC_OFF = LDSCTL_OFF + 320;
constexpr int LDS_BYTES = 147456;
#define GAS __attribute__((address_space(1)))
#define LAS __attribute__((address_space(3)))
typedef unsigned short bf16;
typedef unsigned v4u __attribute__((ext_vector_type(4)));
typedef float f32x4 __attribute__((ext_vector_type(4)));
typedef short bf16x8 __attribute__((ext_vector_type(8)));
typedef GAS unsigned gu32;
typedef GAS unsigned long long gu64;
#define RLX_AGENT __ATOMIC_RELAXED, __HIP_MEMORY_SCOPE_AGENT
#define LDS_WAIT() asm volatile("s_waitcnt lgkmcnt(0)" ::: "memory")
#define VM_WAIT() asm volatile("s_waitcnt vmcnt(0)" ::: "memory")
__device__ __forceinline__ unsigned long long rt() { return __builtin_amdgcn_s_memrealtime(); }

#define XB_TMO      128
#define XB_XCNT(j)  (256  + 64 * (j))
#define XB_XSUB(j)  (1280 + 64 * (j))
#define XB_XGEN(j)  (2304 + 64 * (j))
#define XB_TOP      3328
#define XB_TOPGEN   3392
#define XCD_BAR_WORDS 3456
#define XB_SPIN_CAP (1u << 18)

__device__ __forceinline__ unsigned xb_ld(unsigned* p)              { return __hip_atomic_load(p, __ATOMIC_RELAXED, __HIP_MEMORY_SCOPE_AGENT); }
__device__ __forceinline__ unsigned xb_add(unsigned* p, unsigned v) { return __hip_atomic_fetch_add(p, v, __ATOMIC_RELAXED, __HIP_MEMORY_SCOPE_AGENT); }
__device__ __forceinline__ unsigned xb_xcc_id() { return (unsigned)__builtin_amdgcn_s_getreg((3 << 11) | 20) & 0xFu; }
#define XB_SPIN(cond, bar) do { unsigned _sp = 0; while (cond) { __builtin_amdgcn_s_sleep(1); \
    if ((++_sp & 255u) == 0u) { if (xb_ld(&(bar)[XB_TMO])) break; if (_sp > XB_SPIN_CAP) { atomicAdd(&(bar)[XB_TMO], 1u); break; } } } } while (0)

struct XcdBarrier {
    unsigned* bar; unsigned x;
    volatile LAS unsigned* st;
};

__device__ __forceinline__ XcdBarrier xcd_barrier_post(unsigned* bar, volatile LAS unsigned* st) {
    XcdBarrier b; b.bar = bar; b.x = xb_xcc_id(); b.st = st;
    if (threadIdx.x == 0) (void)xb_add(&bar[XB_XCNT(b.x)], 1u);
    return b;
}
__device__ __forceinline__ void xcd_barrier_complete(unsigned* bar, unsigned x, unsigned& nloc, unsigned& nx) {
    const unsigned G = gridDim.x * gridDim.y * gridDim.z;
    unsigned sum, cnt, mine, sp = 0u;
    for (;;) {
        sum = 0u; cnt = 0u; mine = 0u;
#pragma unroll
        for (unsigned j = 0; j < 16; ++j) { const unsigned c = xb_ld(&bar[XB_XCNT(j)]); sum += c; cnt += (c > 0u) ? 1u : 0u; mine = (j == x) ? c : mine; }
        if (sum == G) break;
        __builtin_amdgcn_s_sleep(1);
        if ((++sp & 255u) == 0u) { if (xb_ld(&bar[XB_TMO])) break; if (sp > XB_SPIN_CAP) { atomicAdd(&bar[XB_TMO], 1u); break; } }
    }
    nloc = mine > 0u ? mine : 1u; nx = cnt > 0u ? cnt : 1u;
}

__device__ __forceinline__ void xcd_barrier(const XcdBarrier& b) {
    asm volatile("s_waitcnt vmcnt(0)" ::: "memory");
    __syncthreads();
    if (threadIdx.x == 0) {
        unsigned* bar = b.bar;
        __builtin_amdgcn_s_waitcnt(0);
        unsigned nloc = b.st[0], nx = b.st[1];
        if (nloc == 0u) { xcd_barrier_complete(bar, b.x, nloc, nx); b.st[0] = nloc; b.st[1] = nx; }
        const unsigned old = xb_add(&bar[XB_XSUB(b.x)], 1u);
        const unsigned gen = old / nloc;
        if (old + 1u == (gen + 1u) * nloc) {
            __builtin_amdgcn_fence(__ATOMIC_RELEASE, "agent");
            asm volatile("s_waitcnt vmcnt(0)" ::: "memory");
            const unsigned og = xb_add(&bar[XB_TOP], 1u);
            const unsigned tg = og / nx;
            if (og + 1u == (tg + 1u) * nx) xb_add(&bar[XB_TOPGEN], 1u);
            else XB_SPIN(xb_ld(&bar[XB_TOPGEN]) == tg, bar);
            __builtin_amdgcn_fence(__ATOMIC_ACQUIRE, "agent");
            xb_add(&bar[XB_XGEN(b.x)], 1u);
            asm volatile("s_waitcnt vmcnt(0)" ::: "memory");
        } else {
            XB_SPIN(xb_ld(&bar[XB_XGEN(b.x)]) == gen, bar);
            __builtin_amdgcn_fence(__ATOMIC_ACQUIRE, "agent");
            asm volatile("s_waitcnt vmcnt(0)" ::: "memory");
        }
    }
    __syncthreads();
}

struct Frame {
    LAS unsigned char* lds;
    volatile LAS unsigned* MISC;
    gu32* ctl;
    int tid, lane, wave;
    int vcu, G;
    const float* const* in; float* out; unsigned char* ws;
};
typedef float f32x16 __attribute__((ext_vector_type(16)));
typedef __bf16 bf16x2v __attribute__((ext_vector_type(2)));
typedef float f32x2 __attribute__((ext_vector_type(2)));
__device__ __forceinline__ unsigned pk2(float lo, float hi) { f32x2 v = {lo, hi}; bf16x2v b = __builtin_convertvector(v, bf16x2v); return __builtin_bit_cast(unsigned, b); }
__device__ __forceinline__ unsigned short f2bf1(float f) { return (unsigned short)(pk2(f, 0.f) & 0xffffu); }
__device__ __forceinline__ float bf2f(unsigned short b) { return __builtin_bit_cast(float, (unsigned)b << 16); }
__device__ __forceinline__ float fsigmoid(float x) { return __builtin_amdgcn_rcpf(1.0f + __expf(-x)); }
__device__ __forceinline__ float fsilu(float x) { return x * fsigmoid(x); }
__device__ __forceinline__ float wave_sum(float v) {
#pragma unroll
    for (int o = 1; o < 64; o <<= 1) v += __shfl_xor(v, o);
    return v;
}
template <int N> __device__ __forceinline__ float treduce(float (&v)[N], int lane) {
#pragma unroll
    for (int n = N / 2; n >= 1; n >>= 1) { const bool up = (lane & n) != 0;
#pragma unroll
        for (int i = 0; i < n; ++i) { const float a = v[i], b = v[i + n]; const float keep = up ? b : a, send = up ? a : b; v[i] = keep + __shfl_xor(send, n); } }
    float s = v[0];
#pragma unroll
    for (int m = N; m < 64; m <<= 1) s += __shfl_xor(s, m);
    return s;
}
__host__ __device__ __forceinline__ int kperm(int o) { const int q = (o >> 2) & 3; return (o & ~12) | ((q == 1 ? 2 : q == 2 ? 1 : q) << 2); }
enum { I_XP = 0, I_XS, I_SD, I_SQ, I_SC, I_META, I_F1N, I_F1W1, I_F1W3, I_F1W2, I_MIXN, I_WIN, I_QCW, I_ALOG, I_DTB, I_ONORM, I_CW, I_CB, I_CNORM, I_WOUT, I_F2N, I_F2W1, I_F2W3, I_F2W2, I_FINN };

__device__ __forceinline__ void p0_transpose_item(const float* W, int N, int K, int k0, int ncol0, int nvalid, const float* gain, bf16* WT, int drow0, LAS float* scr, int lane) {
    const int n = lane & 31;
#pragma unroll 8
    for (int i = 0; i < 32; ++i) { const int kk = 2 * i + (lane >> 5); float v = 0.f;
        if (n < nvalid) { v = W[(size_t)(k0 + kk) * N + ncol0 + n]; if (gain) v *= gain[k0 + kk]; }
        scr[kk * 33 + n] = v; }
    LDS_WAIT(); asm volatile("" ::: "memory");
    const int c = lane & 7;
#pragma unroll
    for (int j = 0; j < 4; ++j) { const int nn = (lane >> 3) + 8 * j; const LAS float* s = scr + (8 * c) * 33 + nn;
        v4u o; o.x = pk2(s[0 * 33], s[1 * 33]); o.y = pk2(s[2 * 33], s[3 * 33]); o.z = pk2(s[4 * 33], s[5 * 33]); o.w = pk2(s[6 * 33], s[7 * 33]);
        *(GAS v4u*)(WT + (size_t)(drow0 + nn) * K + k0 + 8 * c) = o; }
    LDS_WAIT(); asm volatile("" ::: "memory");
}
__device__ __forceinline__ const float* h0_row(const Frame& F, int row) {
    if (row < MPR) { const int b = row / LP, t = row - b * LP; return (t < 16) ? F.in[I_META] + t * D : F.in[I_XP] + ((size_t)b * 2048 + (t - 16)) * D; }
    if (row < MREAL) return F.in[I_XS] + (size_t)(row - MPR) * D;
    return nullptr;
}
__device__ __forceinline__ void p0_prologue(Frame& F) {
    LAS float* scr = (LAS float*)(F.lds + RING_OFF + F.wave * 16384);
    const int gw = F.vcu * NWAVES + F.wave, NGW = F.G * NWAVES;
    unsigned char* ws = F.ws;
    constexpr int I13 = 176 * 16, I2 = 32 * 44, IIN = 104 * 16, IOUT = 32 * 16;
    constexpr int NITEMS = 2 * I13 + 2 * I2 + IIN + IOUT;
    for (int it = gw; it < NITEMS; it += NGW) {
        int r = it;
        if (r < 2 * I13) {
            const int second = r >= I13; r -= second * I13; const int dg = r / 16, kb = r % 16, drow0 = 32 * dg, p = drow0 >> 8, w = drow0 & 255;
            const float* src = second ? (w >= 128 ? F.in[I_F2W3] : F.in[I_F2W1]) : (w >= 128 ? F.in[I_F1W3] : F.in[I_F1W1]); const float* gsrc = second ? F.in[I_F2N] : F.in[I_F1N];
            p0_transpose_item(src, DFF, D, 64 * kb, 128 * p + (w & 127), 32, gsrc, (bf16*)(ws + (second ? WS_W13B : WS_W13A)), drow0, scr, F.lane); continue; }
        r -= 2 * I13;
        if (r < 2 * I2) { const int second = r >= I2; r -= second * I2; const int dg = r / 44, kb = r % 44;
            p0_transpose_item(second ? F.in[I_F2W2] : F.in[I_F1W2], D, DFF, 64 * kb, 32 * dg, 32, nullptr, (bf16*)(ws + (second ? WS_W2B : WS_W2A)), 32 * dg, scr, F.lane); continue; }
        r -= 2 * I2;
        if (r < IIN) { const int dg = r / 16, kb = r % 16, drow0 = 32 * dg; int ncol0 = drow0, nvalid = 32;
            if (drow0 >= 3072) { ncol0 = 2048; nvalid = (drow0 == 3072) ? 8 : 0; }
            else if (drow0 >= 2048) { const int dd = drow0 - 2048, j = dd >> 8, w = dd & 255; ncol0 = (w < 128 ? 2056 : 2568) + 128 * j + (w & 127); }
            p0_transpose_item(F.in[I_WIN], NIN, D, 64 * kb, ncol0, nvalid, F.in[I_MIXN], (bf16*)(ws + WS_WIN), drow0, scr, F.lane); continue; }
        r -= IIN;
        { const int dg = r / 16, kb = r % 16; p0_transpose_item(F.in[I_WOUT], D, D, 64 * kb, 32 * dg, 32, nullptr, (bf16*)(ws + WS_WOUT), 32 * dg, scr, F.lane); }
    }
    bf16* UA = (bf16*)(ws + WS_UA); float* SSA = (float*)(ws + WS_SSA);
    for (int m = gw; m < MPAD; m += NGW) {
        const float* src = h0_row(F, m);
        f32x4 v[4]; float s = 0.f;
#pragma unroll
        for (int j = 0; j < 4; ++j) { v[j] = src ? ((const GAS f32x4*)src)[F.lane + 64 * j] : (f32x4){0.f, 0.f, 0.f, 0.f}; s += (v[j].x * v[j].x + v[j].y * v[j].y) + (v[j].z * v[j].z + v[j].w * v[j].w); }
        s = wave_sum(s);
        GAS unsigned long long* o8 = (GAS unsigned long long*)(UA + (size_t)m * D) + F.lane;
#pragma unroll
        for (int j = 0; j < 4; ++j) o8[64 * j] = (unsigned long long)pk2(v[j].x, v[j].y) | ((unsigned long long)pk2(v[j].z, v[j].w) << 32);
        if (F.lane < 16) SSA[(size_t)m * 16 + F.lane] = (F.lane == 0) ? s : 0.f;
    }
}

#define MFMA32(a, b, c) __builtin_amdgcn_mfma_f32_32x32x16_bf16((a), (b), (c), 0, 0, 0)
struct PrepUnit { int row0, ntok, prevkind, h; const float* sq; bf16 *NW, *QG, *KDT, *UT, *ATT; float* DL; };
template <int R> __device__ __forceinline__ void prep_unit(Frame& F, const PrepUnit& U, const bf16* QKV, const float* BA) {
    LAS unsigned char* L = F.lds;
    LAS float* AM = (LAS float*)(L + 34816);
    LAS float* sBeta = (LAS float*)(L + 51200); LAS float* sGc = (LAS float*)(L + 51456); LAS float* sEg = (LAS float*)(L + 51712); LAS float* sEk = (LAS float*)(L + 51968);
    LAS float* sPart = (LAS float*)(L + 52224); LAS float* sRs = (LAS float*)(L + 53248);
    const int tid = F.tid, lane = F.lane, wave = F.wave, role = wave >> 1, ch = tid & 127;
    float val[R];
    if (role < 3) {
        const int chan = (role == 0 ? 1024 : role == 1 ? 512 : 0) + U.h * 128 + ch;
        const float* cw = F.in[I_QCW];
        const float w0 = cw[chan], w1 = cw[1536 + chan], w2 = cw[3072 + chan], w3 = cw[4608 + chan];
        float xm3 = 0.f, xm2 = 0.f, xm1 = 0.f;
        if (U.prevkind == 1) { xm3 = bf2f(QKV[(size_t)(U.row0 - 3) * 1536 + chan]); xm2 = bf2f(QKV[(size_t)(U.row0 - 2) * 1536 + chan]); xm1 = bf2f(QKV[(size_t)(U.row0 - 1) * 1536 + chan]); }
        else if (U.prevkind == 2) { xm3 = U.sq[chan]; xm2 = U.sq[1536 + chan]; xm1 = U.sq[3072 + chan]; }
#pragma unroll
        for (int t = 0; t < R; ++t) {
            float xt = 0.f; if (t < U.ntok) xt = bf2f(QKV[(size_t)(U.row0 + t) * 1536 + chan]);
            const float y = w0 * xm3 + w1 * xm2 + w2 * xm1 + w3 * xt;
            val[t] = (t < U.ntok) ? fsilu(y) : 0.f;
            xm3 = xm2; xm2 = xm1; xm1 = xt;
        }
    } else {
#pragma unroll
        for (int t = 0; t < R; ++t) val[t] = 0.f;
        if (wave == 6) {
            float beta = 0.f, g = 0.f;
            if (lane < U.ntok) { const float* ba = BA + (size_t)(U.row0 + lane) * 8; beta = fsigmoid(ba[U.h]);
                const float x = ba[4 + U.h] + F.in[I_DTB][U.h]; const float sp = (x > 20.f) ? x : log1pf(__expf(x)); g = -__expf(F.in[I_ALOG][U.h]) * sp; }
            float gc = g;
#pragma unroll
            for (int d = 1; d < 64; d <<= 1) { const float o = __shfl_up(gc, d); if (lane >= d) gc += o; }
            const float glast = __shfl(gc, 63);
            sBeta[lane] = beta; sGc[lane] = gc; sEg[lane] = __expf(gc); sEk[lane] = __expf(glast - gc);
            if (lane == 0) *U.DL = __expf(glast);
        }
    }
    if (role == 1 || role == 2) {
        float sq[R];
#pragma unroll
        for (int t = 0; t < R; ++t) sq[t] = val[t] * val[t];
        const float mine = treduce<R>(sq, lane);
        if (lane < R) sPart[((role - 1) * 2 + (wave & 1)) * 64 + lane] = mine;
    }
    __syncthreads();
    if (tid < 128) { const int rr = tid >> 6, t = tid & 63; if (t < R) { const float s = sPart[(rr * 2) * 64 + t] + sPart[(rr * 2 + 1) * 64 + t];
        sRs[rr * 64 + t] = (1.0f / sqrtf(s + EPS)) * (rr ? 0.08838834764831845f : 1.0f); } }
    __syncthreads();
    if (role == 1 || role == 2) {
        LAS unsigned char* dst = L + (role == 1 ? 0 : 17408) + ch * 2;
#pragma unroll
        for (int t = 0; t < R; ++t) { val[t] *= sRs[(role - 1) * 64 + t]; *(LAS unsigned short*)(dst + t * 272) = f2bf1(val[t]); }
        if (R < 32) {
#pragma unroll
            for (int t = R; t < 32; ++t) *(LAS unsigned short*)(dst + t * 272) = (unsigned short)0;
        }
    }
    __syncthreads();
    float X[R];
    if (role < 2) {
#pragma unroll
        for (int i = 0; i < R; ++i) X[i] = (role == 0) ? sBeta[i] * val[i] : sBeta[i] * sEg[i] * val[i];
        if (role == 1) {
#pragma unroll
            for (int c8 = 0; c8 < R / 8; ++c8) { float e[8];
#pragma unroll
                for (int j = 0; j < 8; ++j) { const int c = kperm(8 * c8 + j); e[j] = val[c] * sEk[c]; }
                v4u o; o.x = pk2(e[0], e[1]); o.y = pk2(e[2], e[3]); o.z = pk2(e[4], e[5]); o.w = pk2(e[6], e[7]);
                *(GAS v4u*)(U.KDT + ch * R + 8 * c8) = o; }
        }
    } else {
#pragma unroll
        for (int i = 0; i < R; ++i) X[i] = 0.f;
        if (role == 2) { const int kp = kperm(ch);
#pragma unroll
            for (int c = 0; c < R; ++c) U.QG[c * 128 + kp] = f2bf1(val[c] * sEg[c]); }
    }
    {
        const int r = lane & 31, hh = lane >> 5;
        int kind = -1, ti = 0, tj = 0;
        if (R == 64) { if (wave < 6) { kind = wave / 3; const int q = wave % 3; ti = (q == 1) ? 0 : 1; tj = (q == 2) ? 1 : 0; } }
        else { if (wave == 1) kind = 0; else if (wave == 4) kind = 1; }
        if (kind >= 0) {
            const LAS unsigned char* Ab = L + (kind ? 17408 : 0) + (32 * ti + r) * 272 + hh * 16;
            const LAS unsigned char* Bb = L + (32 * tj + r) * 272 + hh * 16;
            f32x16 acc;
#pragma unroll
            for (int i = 0; i < 16; ++i) acc[i] = 0.f;
#pragma unroll
            for (int ks = 0; ks < 8; ++ks) { const bf16x8 a = *(const LAS bf16x8*)(Ab + ks * 32); const bf16x8 b = *(const LAS bf16x8*)(Bb + ks * 32); acc = MFMA32(a, b, acc); }
            const int col = 32 * tj + r; const float gcc = sGc[col];
#pragma unroll
            for (int i = 0; i < 16; ++i) { const int row = 32 * ti + (i & 3) + 8 * (i >> 2) + 4 * hh;
                const float e = (row >= col) ? __expf(sGc[row] - gcc) : 0.f;
                if (kind == 0) AM[row * 64 + col] = (row > col) ? sBeta[row] * acc[i] * e : 0.f;
                else if (row < R && col < R) U.ATT[row * R + kperm(col)] = f2bf1(acc[i] * e); }
        }
    }
    __syncthreads();
    if (role < 2) {
#pragma unroll
        for (int i = 1; i < R; ++i) { float a0 = 0.f, a1 = 0.f;
#pragma unroll
            for (int j = 0; j < i; ++j) { if (j & 1) a1 += AM[i * 64 + j] * X[j]; else a0 += AM[i * 64 + j] * X[j]; }
            X[i] -= (a0 + a1); }
        if (role == 0) {
#pragma unroll
            for (int c8 = 0; c8 < R / 8; ++c8) { v4u o; o.x = pk2(X[8 * c8], X[8 * c8 + 1]); o.y = pk2(X[8 * c8 + 2], X[8 * c8 + 3]); o.z = pk2(X[8 * c8 + 4], X[8 * c8 + 5]); o.w = pk2(X[8 * c8 + 6], X[8 * c8 + 7]);
                *(GAS v4u*)(U.UT + ch * R + 8 * c8) = o; }
        } else {
            const int kp = kperm(ch);
#pragma unroll
            for (int c = 0; c < R; ++c) U.NW[c * 128 + kp] = f2bf1(-X[c]);
        }
    }
    __syncthreads();
}
template <int NT> __device__ __forceinline__ void conv_job(Frame& F, int kind, int seq, int t0, const bf16* CIN, bf16* X3) {
    LAS float* tile = (LAS float*)F.lds;
    LAS float* sPart = (LAS float*)(F.lds + 126976);
    LAS float* sRstd = (LAS float*)(F.lds + 129024);
    const int ch = F.tid, lane = F.lane, wave = F.wave;
    const int rowbase = (kind == 0) ? seq * LP : MPR + seq * 8;
    for (int p = F.tid; p < (NT + 30) * 64; p += 512) { const int e = p >> 6, seg = p & 63, tp = t0 - 30 + e;
        f32x4 lo = {0.f, 0.f, 0.f, 0.f}, hi = {0.f, 0.f, 0.f, 0.f};
        if (tp >= 0) { const v4u q = *(const GAS v4u*)(CIN + (size_t)(rowbase + tp) * 512 + seg * 8);
            lo = (f32x4){__builtin_bit_cast(float, q.x << 16), __builtin_bit_cast(float, q.x & 0xffff0000u), __builtin_bit_cast(float, q.y << 16), __builtin_bit_cast(float, q.y & 0xffff0000u)};
            hi = (f32x4){__builtin_bit_cast(float, q.z << 16), __builtin_bit_cast(float, q.z & 0xffff0000u), __builtin_bit_cast(float, q.w << 16), __builtin_bit_cast(float, q.w & 0xffff0000u)}; }
        else if (kind == 1) { const GAS f32x4* sp = (const GAS f32x4*)(F.in[I_SC] + ((size_t)seq * 30 + (30 + tp)) * 512 + seg * 8); lo = sp[0]; hi = sp[1]; }
        *(LAS f32x4*)(tile + e * 512 + seg * 8) = lo; *(LAS f32x4*)(tile + e * 512 + seg * 8 + 4) = hi; }
    const float* cwp = F.in[I_CW];
    float w[31];
#pragma unroll
    for (int j = 0; j < 31; ++j) w[j] = cwp[j * 512 + ch];
    const float bias = F.in[I_CB][ch], gn = F.in[I_CNORM][ch];
    __syncthreads();
    float sq[NT];
#pragma unroll
    for (int g = 0; g < NT / 8; ++g) { float ext[38];
#pragma unroll
        for (int i = 0; i < 38; ++i) ext[i] = tile[(8 * g + i) * 512 + ch];
#pragma unroll
        for (int t = 0; t < 8; ++t) { float a = bias;
#pragma unroll
            for (int j = 0; j < 31; ++j) a += w[j] * ext[t + j];
            tile[(8 * g + t) * 512 + ch] = a; sq[8 * g + t] = a * a; } }
    const float mine = treduce<NT>(sq, lane);
    if (lane < NT) sPart[wave * 64 + lane] = mine;
    __syncthreads();
    if (F.tid < NT) { float s = 0.f;
#pragma unroll
        for (int wv = 0; wv < 8; ++wv) s += sPart[wv * 64 + F.tid];
        sRstd[F.tid] = 1.0f / sqrtf(s * (1.0f / 512.0f) + EPS); }
    __syncthreads();
#pragma unroll
    for (int t = 0; t < NT; ++t) { const float y = tile[t * 512 + ch] * sRstd[t] * gn; X3[(size_t)(rowbase + t0 + t) * 1024 + 512 + ch] = f2bf1(fsilu(y)); }
    __syncthreads();
}
__device__ __forceinline__ void p4_prep(Frame& F) {
    unsigned char* ws = F.ws;
    const bf16* QKV = (const bf16*)F.out; const float* BA = (const float*)(ws + WS_BA); const bf16* CIN = (const bf16*)(ws + WS_CIN); bf16* X3 = (bf16*)(ws + WS_UA);
    for (int f = F.vcu; f < 1024; f += F.G) {
        const int b = f >> 7, c1 = (f >> 2) & 31, h = f & 3;
        PrepUnit U; U.row0 = b * LP + 16 + 64 * c1; U.ntok = 64; U.prevkind = 1; U.h = h; U.sq = nullptr;
        U.NW = (bf16*)(ws + WS_NW) + (size_t)f * 8192; U.QG = (bf16*)(ws + WS_QG) + (size_t)f * 8192; U.KDT = (bf16*)(ws + WS_KDT) + (size_t)f * 8192; U.UT = (bf16*)(ws + WS_UT) + (size_t)f * 8192;
        U.ATT = (bf16*)(ws + WS_ATT) + (size_t)f * 4096; U.DL = (float*)(ws + WS_DL) + f;
        prep_unit<64>(F, U, QKV, BA);
    }
    for (int s = F.vcu; s < 544; s += F.G) {
        PrepUnit U; U.h = s & 3; unsigned char* base = ws + WS_SM + (size_t)s * SM_STRIDE;
        if (s < 32) { U.row0 = (s >> 2) * LP; U.ntok = 16; U.prevkind = 0; U.sq = nullptr; }
        else { const int sq = (s - 32) >> 2; U.row0 = MPR + sq * 8; U.ntok = 8; U.prevkind = 2; U.sq = F.in[I_SQ] + (size_t)sq * 3 * 1536; }
        U.NW = (bf16*)base; U.QG = (bf16*)(base + 4096); U.KDT = (bf16*)(base + 8192); U.UT = (bf16*)(base + 12288); U.ATT = (bf16*)(base + 16384); U.DL = (float*)(ws + WS_DL) + 1024 + s;
        prep_unit<16>(F, U, QKV, BA);
    }
    for (int j = F.vcu; j < 392; j += F.G) {
        if (j < 256) { conv_job<32>(F, 0, j >> 5, 64 * (j & 31), CIN, X3); conv_job<32>(F, 0, j >> 5, 64 * (j & 31) + 32, CIN, X3); }
        else if (j < 264) conv_job<16>(F, 0, j - 256, 2048, CIN, X3);
        else conv_job<8>(F, 1, j - 264, 0, CIN, X3);
    }
    float* out = F.out;
    const int gt = F.vcu * 512 + F.tid, NT = F.G * 512;
    for (int i = gt; i < 36864; i += NT) { const int c = i % 1536, r = i / 1536, b = r / 3, k = r % 3; out[OUT_QP + i] = bf2f(QKV[(size_t)(b * LP + 2061 + k) * 1536 + c]); }
    for (int i = gt; i < 122880; i += NT) { const int c = i & 511, r = i >> 9, b = r / 30, k = r % 30; out[OUT_CP + i] = bf2f(CIN[(size_t)(b * LP + 2034 + k) * 512 + c]); }
    for (int i = gt; i < 589824; i += NT) { const int c = i % 1536, r = i / 1536, s = r / 3, k = r % 3; out[OUT_QS + i] = bf2f(QKV[(size_t)(MPR + s * 8 + 5 + k) * 1536 + c]); }
    for (int i = gt; i < 1966080; i += NT) { const int c = i & 511, r = i >> 9, s = r / 30, k = r % 30;
        out[OUT_CS + i] = (k < 22) ? F.in[I_SC][((size_t)s * 30 + 8 + k) * 512 + c] : bf2f(CIN[(size_t)(MPR + s * 8 + (k - 22)) * 512 + c]); }
}

constexpr int SC_NW = 0, SC_QG = 17408, SC_ATT = 34816, SC_KDT = 44032, SC_UT = 62464, SC_RED = 79872, SC_RSTD = 80896, SC_IMG = 79872;
__device__ __forceinline__ bf16x8 pack8(const f32x16& x, int s) { v4u p; p.x = pk2(x[8 * s], x[8 * s + 1]); p.y = pk2(x[8 * s + 2], x[8 * s + 3]); p.z = pk2(x[8 * s + 4], x[8 * s + 5]); p.w = pk2(x[8 * s + 6], x[8 * s + 7]); return __builtin_bit_cast(bf16x8, p); }
__device__ __forceinline__ void scan_load(Frame& F, int R, const bf16* gNW, const bf16* gQG, const bf16* gATT, const bf16* gKDT, const bf16* gUT) {
    LAS unsigned char* L = F.lds; const int tid = F.tid;
    if (R < 64) { for (int p = tid; p < SC_IMG / 16; p += 512) *(LAS v4u*)(L + p * 16) = (v4u){0u, 0u, 0u, 0u}; __syncthreads(); }
    const int sh = (R == 64) ? 3 : 1;
    for (int p = tid; p < R * 16; p += 512) { const int row = p >> 4, seg = p & 15; *(LAS v4u*)(L + SC_NW + row * 272 + seg * 16) = ((const GAS v4u*)gNW)[p]; *(LAS v4u*)(L + SC_QG + row * 272 + seg * 16) = ((const GAS v4u*)gQG)[p]; }
    for (int p = tid; p < (R << sh); p += 512) { const int row = p >> sh, seg = p & ((1 << sh) - 1); *(LAS v4u*)(L + SC_ATT + row * 144 + seg * 16) = ((const GAS v4u*)gATT)[p]; }
    for (int p = tid; p < (128 << sh); p += 512) { const int row = p >> sh, seg = p & ((1 << sh) - 1); *(LAS v4u*)(L + SC_KDT + row * 144 + seg * 16) = ((const GAS v4u*)gKDT)[p]; }
    for (int p = tid; p < (128 << (sh + 1)); p += 512) { const int row = p >> (sh + 1), seg = p & ((2 << sh) - 1); *(LAS unsigned long long*)(L + SC_UT + row * 136 + seg * 8) = ((const GAS unsigned long long*)gUT)[p]; }
    __syncthreads();
}
constexpr int SC_OB0 = 79872, SC_OB1 = 97280;
struct ScanPF { v4u nw[2], qg[2], att, kdt[2]; unsigned long long ut[4]; float dl; };
__device__ __forceinline__ void scan_pf_issue(ScanPF& P, int tid, const bf16* gNW, const bf16* gQG, const bf16* gATT, const bf16* gKDT, const bf16* gUT, const float* gDL) {
#pragma unroll
    for (int i = 0; i < 2; ++i) { P.nw[i] = ((const GAS v4u*)gNW)[tid + 512 * i]; P.qg[i] = ((const GAS v4u*)gQG)[tid + 512 * i]; P.kdt[i] = ((const GAS v4u*)gKDT)[tid + 512 * i]; }
    P.att = ((const GAS v4u*)gATT)[tid];
#pragma unroll
    for (int i = 0; i < 4; ++i) P.ut[i] = ((const GAS unsigned long long*)gUT)[tid + 512 * i];
    P.dl = *gDL;
}
__device__ __forceinline__ void scan_pf_write(const ScanPF& P, LAS unsigned char* L, int tid) {
#pragma unroll
    for (int i = 0; i < 2; ++i) { const int p = tid + 512 * i;
        *(LAS v4u*)(L + SC_NW + (p >> 4) * 272 + (p & 15) * 16) = P.nw[i]; *(LAS v4u*)(L + SC_QG + (p >> 4) * 272 + (p & 15) * 16) = P.qg[i];
        *(LAS v4u*)(L + SC_KDT + (p >> 3) * 144 + (p & 7) * 16) = P.kdt[i]; }
    *(LAS v4u*)(L + SC_ATT + (tid >> 3) * 144 + (tid & 7) * 16) = P.att;
#pragma unroll
    for (int i = 0; i < 4; ++i) { const int p = tid + 512 * i; *(LAS unsigned long long*)(L + SC_UT + (p >> 4) * 136 + (p & 15) * 8) = P.ut[i]; }
}
__device__ __forceinline__ void scan_gate(const LAS unsigned char* OB, int gt, int row0, int ntok, int h, const bf16* Z, bf16* X3, const float* onp) {
    const int c = gt >> 2, cg = (gt & 3) * 32;
    const bool live = c < ntok; const size_t row = (size_t)(row0 + (live ? c : 0));
    v4u zv[4];
#pragma unroll
    for (int j = 0; j < 4; ++j) zv[j] = live ? *(const GAS v4u*)(Z + row * 512 + h * 128 + cg + 8 * j) : (v4u){0u, 0u, 0u, 0u};
    float ov[32]; float ss = 0.f;
#pragma unroll
    for (int j = 0; j < 4; ++j) { const v4u q = *(const LAS v4u*)(OB + c * 272 + cg * 2 + j * 16);
#pragma unroll
        for (int e = 0; e < 4; ++e) { const unsigned u = q[e]; ov[8 * j + 2 * e] = __builtin_bit_cast(float, u << 16); ov[8 * j + 2 * e + 1] = __builtin_bit_cast(float, u & 0xffff0000u); } }
#pragma unroll
    for (int e = 0; e < 32; ++e) ss += ov[e] * ov[e];
    ss += __shfl_xor(ss, 1); ss += __shfl_xor(ss, 2);
    const float rs = 1.0f / sqrtf(ss * (1.0f / 128.0f) + EPS);
    if (live) {
#pragma unroll
        for (int j = 0; j < 4; ++j) { v4u w;
#pragma unroll
            for (int e = 0; e < 4; ++e) { const unsigned zu = zv[j][e]; const float z0 = __builtin_bit_cast(float, zu << 16), z1 = __builtin_bit_cast(float, zu & 0xffff0000u);
                const float g0 = onp[cg + 8 * j + 2 * e], g1 = onp[cg + 8 * j + 2 * e + 1];
                w[e] = pk2(ov[8 * j + 2 * e] * rs * g0 * fsilu(z0), ov[8 * j + 2 * e + 1] * rs * g1 * fsilu(z1)); }
            *(GAS v4u*)(X3 + row * 1024 + h * 128 + cg + 8 * j) = w; }
    }
}
__device__ __forceinline__ void scan_chain(Frame& F, int kind, int idx) {
    LAS unsigned char* L = F.lds; unsigned char* ws = F.ws;
    const int lane = F.lane, w = F.wave, r = lane & 31, hh = lane >> 5, h = idx & 3, sq = idx >> 2;
    const bf16* Z = (const bf16*)(ws + WS_Z); bf16* X3 = (bf16*)(ws + WS_UA);
    f32x16 S[4];
    const int dvc = 32 * (w & 3) + r;
    if (kind == 1 && w < 4) { const float* sp = F.in[I_SD] + ((size_t)sq * 4 + h) * 16384;
#pragma unroll
        for (int kb = 0; kb < 4; ++kb)
#pragma unroll
            for (int i = 0; i < 16; ++i) S[kb][i] = sp[(32 * kb + (i & 3) + 8 * (i >> 2) + 4 * hh) * 128 + dvc]; }
    else {
#pragma unroll
        for (int kb = 0; kb < 4; ++kb)
#pragma unroll
            for (int i = 0; i < 16; ++i) S[kb][i] = 0.f; }
    const float* onp = F.in[I_ONORM];
    const int nchunks = (kind == 0) ? 33 : 1;
    const int s0 = (kind == 0) ? idx : 32 + idx; const unsigned char* sb = ws + WS_SM + (size_t)s0 * SM_STRIDE;
    __syncthreads();
    scan_load(F, 16, (const bf16*)sb, (const bf16*)(sb + 4096), (const bf16*)(sb + 16384), (const bf16*)(sb + 8192), (const bf16*)(sb + 12288));
    float dl = ((const float*)(ws + WS_DL))[1024 + s0];
    int row0 = (kind == 0) ? sq * LP : MPR + sq * 8, ntok = (kind == 0) ? 16 : 8;
    int prow0 = 0, pntok = 0;
    for (int ci = 0; ci < nchunks; ++ci) {
        ScanPF P;
        const bool more = ci + 1 < nchunks;
        if (more) { const int f = sq * 128 + ci * 4 + h;
            scan_pf_issue(P, F.tid, (const bf16*)(ws + WS_NW) + (size_t)f * 8192, (const bf16*)(ws + WS_QG) + (size_t)f * 8192, (const bf16*)(ws + WS_ATT) + (size_t)f * 4096,
                          (const bf16*)(ws + WS_KDT) + (size_t)f * 8192, (const bf16*)(ws + WS_UT) + (size_t)f * 8192, (const float*)(ws + WS_DL) + f); }
        LAS unsigned char* OB = L + ((ci & 1) ? SC_OB1 : SC_OB0);
        if (w < 4) {
            f32x16 o[2], vn[2];
#pragma unroll
            for (int cb = 0; cb < 2; ++cb) {
#pragma unroll
                for (int i = 0; i < 16; ++i) o[cb][i] = 0.f;
#pragma unroll
                for (int q4 = 0; q4 < 4; ++q4) { const unsigned long long u8 = *(const LAS unsigned long long*)(L + SC_UT + dvc * 136 + (32 * cb + 8 * q4 + 4 * hh) * 2);
                    vn[cb][4 * q4 + 0] = bf2f((unsigned short)(u8 & 0xffffu)); vn[cb][4 * q4 + 1] = bf2f((unsigned short)((u8 >> 16) & 0xffffu));
                    vn[cb][4 * q4 + 2] = bf2f((unsigned short)((u8 >> 32) & 0xffffu)); vn[cb][4 * q4 + 3] = bf2f((unsigned short)(u8 >> 48)); } }
#pragma unroll
            for (int kb = 0; kb < 4; ++kb)
#pragma unroll
                for (int s = 0; s < 2; ++s) { const bf16x8 sbf = pack8(S[kb], s);
#pragma unroll
                    for (int cb = 0; cb < 2; ++cb) {
                        const bf16x8 a = *(const LAS bf16x8*)(L + SC_NW + (32 * cb + r) * 272 + (kb * 2 + s) * 32 + hh * 16); vn[cb] = MFMA32(a, sbf, vn[cb]);
                        const bf16x8 a2 = *(const LAS bf16x8*)(L + SC_QG + (32 * cb + r) * 272 + (kb * 2 + s) * 32 + hh * 16); o[cb] = MFMA32(a2, sbf, o[cb]); } }
            bf16x8 vnb[2][2];
#pragma unroll
            for (int cb = 0; cb < 2; ++cb) { vnb[cb][0] = pack8(vn[cb], 0); vnb[cb][1] = pack8(vn[cb], 1); }
#pragma unroll
            for (int kb = 0; kb < 4; ++kb) {
#pragma unroll
                for (int i = 0; i < 16; ++i) S[kb][i] *= dl;
#pragma unroll
                for (int cb = 0; cb < 2; ++cb)
#pragma unroll
                    for (int s = 0; s < 2; ++s) { const bf16x8 a = *(const LAS bf16x8*)(L + SC_KDT + (32 * kb + r) * 144 + (cb * 2 + s) * 32 + hh * 16); S[kb] = MFMA32(a, vnb[cb][s], S[kb]); } }
#pragma unroll
            for (int cb = 0; cb < 2; ++cb)
#pragma unroll
                for (int c2 = 0; c2 <= cb; ++c2)
#pragma unroll
                    for (int s = 0; s < 2; ++s) { const bf16x8 a = *(const LAS bf16x8*)(L + SC_ATT + (32 * cb + r) * 144 + (c2 * 2 + s) * 32 + hh * 16); o[cb] = MFMA32(a, vnb[c2][s], o[cb]); }
#pragma unroll
            for (int cb = 0; cb < 2; ++cb)
#pragma unroll
                for (int i = 0; i < 16; ++i) *(LAS unsigned short*)(OB + (32 * cb + (i & 3) + 8 * (i >> 2) + 4 * hh) * 272 + dvc * 2) = f2bf1(o[cb][i]);
        } else if (ci > 0) {
            scan_gate(L + (((ci - 1) & 1) ? SC_OB1 : SC_OB0), F.tid - 256, prow0, pntok, h, Z, X3, onp);
        }
        prow0 = row0; pntok = ntok;
        __syncthreads();
        if (more) { scan_pf_write(P, L, F.tid); dl = P.dl; row0 = sq * LP + 16 + 64 * ci; ntok = 64; }
        __syncthreads();
    }
    if (w >= 4) scan_gate(L + (((nchunks - 1) & 1) ? SC_OB1 : SC_OB0), F.tid - 256, prow0, pntok, h, Z, X3, onp);
    if (w < 4) { float* dp = F.out + ((kind == 0) ? OUT_DP : OUT_DS) + ((size_t)sq * 4 + h) * 16384;
#pragma unroll
        for (int kb = 0; kb < 4; ++kb)
#pragma unroll
            for (int i = 0; i < 16; ++i) dp[(32 * kb + (i & 3) + 8 * (i >> 2) + 4 * hh) * 128 + dvc] = S[kb][i]; }
}
__device__ __forceinline__ void p5_scan(Frame& F) {
    if (F.vcu < 32) scan_chain(F, 0, F.vcu);
    else for (int u = F.vcu - 32; u < 512; u += F.G - 32) scan_chain(F, 1, u);
}
__device__ __forceinline__ void p9_final(Frame& F) {
    const int gw = F.vcu * NWAVES + F.wave, NGW = F.G * NWAVES;
    const float* H = (const float*)(F.ws + WS_H); const GAS f32x4* gn = (const GAS f32x4*)F.in[I_FINN];
    for (int m = gw; m < MREAL; m += NGW) {
        float* dst;
        if (m < MPR) { const int b = m / LP, t = m - b * LP; if (t < 16) continue; dst = F.out + OUT_YP + ((size_t)b * 2048 + (t - 16)) * D; }
        else dst = F.out + OUT_YS + (size_t)(m - MPR) * D;
        const GAS f32x4* src = (const GAS f32x4*)(H + (size_t)m * D);
        f32x4 v[4]; float s = 0.f;
#pragma unroll
        for (int j = 0; j < 4; ++j) { v[j] = src[F.lane + 64 * j]; s += (v[j].x * v[j].x + v[j].y * v[j].y) + (v[j].z * v[j].z + v[j].w * v[j].w); }
        const float rs = 1.0f / sqrtf(wave_sum(s) * (1.0f / D) + EPS);
#pragma unroll
        for (int j = 0; j < 4; ++j) ((GAS f32x4*)dst)[F.lane + 64 * j] = v[j] * rs * gn[F.lane + 64 * j];
    }
}

#ifndef MK_N_LAUNCHES
#define MK_N_LAUNCHES 1
#endif
constexpr int N_LAUNCHES = MK_N_LAUNCHES;
constexpr int NPHASES = 10;
template <class T> __device__ __forceinline__ T* sgpr_ptr(T* p) {
    const unsigned long long v = (unsigned long long)p; unsigned lo = __builtin_amdgcn_readfirstlane((unsigned)v), hi = __builtin_amdgcn_readfirstlane((unsigned)(v >> 32));
    asm volatile("" : "+s"(lo), "+s"(hi)); return (T*)(((unsigned long long)hi << 32) | lo);
}
struct Args { const float* in[25]; float* out; unsigned char* ws; int ph_lo, ph_hi, li, pad; };
__global__ void __launch_bounds__(NWAVES * 64, 2) mk_fwd(Args args) {
    extern __shared__ __attribute__((aligned(16))) unsigned char lds[];
    Frame F;
    F.lds = (LAS unsigned char*)lds;
    F.MISC = (volatile LAS unsigned*)(F.lds + MISC_OFF);
    F.tid = threadIdx.x; F.lane = F.tid & 63; F.wave = __builtin_amdgcn_readfirstlane(F.tid >> 6);
    F.G = gridDim.x; { const int bx = blockIdx.x; F.vcu = (F.G % 8 == 0) ? (bx % 8) * (F.G / 8) + bx / 8 : bx; }
    F.ws = nullptr; F.out = nullptr; F.in = nullptr; F.ctl = (gu32*)(args.ws + WS_CTL);
    for (int u = F.tid; u < (LDS_BYTES - LDSCTL_OFF) / 4; u += NWAVES * 64) ((LAS unsigned*)(F.lds + LDSCTL_OFF))[u] = 0u;
    __syncthreads();
    XcdBarrier bar; bar.bar = (unsigned*)(F.ctl + CW_BAR); bar.x = 0; bar.st = nullptr;
    if (N_LAUNCHES == 1) bar = xcd_barrier_post((unsigned*)(F.ctl + CW_BAR), F.MISC + 8);
    const int lo = args.ph_lo, hi = args.ph_hi;
#ifndef PHMASK
#define PHMASK 0x3ff
#endif
#define IN(k) (((PHMASK >> (k)) & 1) && lo <= (k) && (k) < hi)
#define SEAM(k) do { if (IN(k) && IN((k) + 1)) xcd_barrier(bar); } while (0)
#define PHASE_PTRS unsigned char* ws = sgpr_ptr(args.ws); float* outp = sgpr_ptr(args.out); const float* const* inp = args.in; \
    bf16* UA = (bf16*)(ws + WS_UA); bf16* HID = (bf16*)(ws + WS_HID); float* H = (float*)(ws + WS_H); float* SSA = (float*)(ws + WS_SSA); float* SSB = (float*)(ws + WS_SSB); \
    bf16* QKV = (bf16*)outp; bf16* U3 = (bf16*)outp; (void)UA; (void)HID; (void)H; (void)SSA; (void)SSB; (void)QKV; (void)U3; (void)inp;
#define PHASE_FRAME Frame Fp = F; { int t_ = threadIdx.x; asm volatile("" : "+v"(t_)); Fp.tid = t_; Fp.lane = t_ & 63; Fp.ws = ws; Fp.out = outp; Fp.in = inp; }

    if (IN(0)) { PHASE_PTRS PHASE_FRAME p0_prologue(Fp); } SEAM(0);
    if (IN(1)) { PHASE_PTRS
        pg8::Gemm g{UA, (const bf16*)(ws + WS_W13A), MPAD, 5632, D}; pg8::StaticOrder S; S.init(MPAD, 5632, F.G, (int)blockIdx.x);
        pg8::EpiSwiGLU E{HID, SSA};
        pg8::gemm_phase<pg8::EpiSwiGLU, pg8::StaticOrder, true, true>(F.lds + RING_OFF, g, S, E);
    } SEAM(1);
    if (IN(2)) { PHASE_PTRS
        pg8::Gemm g{HID, (const bf16*)(ws + WS_W2A), MPAD, D, DFF}; pg8::StaticOrder S; S.init(MPAD, D, F.G, (int)blockIdx.x);
        pg8::EpiResid E{H, UA, SSB, 0.5f, 1, inp[I_XP], inp[I_XS], inp[I_META]};
        pg8::gemm_phase<pg8::EpiResid, pg8::StaticOrder, true, true>(F.lds + RING_OFF, g, S, E);
    } SEAM(2);
    if (IN(3)) { PHASE_PTRS
        pg8::Gemm g{UA, (const bf16*)(ws + WS_WIN), MPAD, NINP, D}; pg8::StaticOrder S; S.init(MPAD, NINP, F.G, (int)blockIdx.x);
        pg8::EpiInProj E{QKV, (bf16*)(ws + WS_Z), (bf16*)(ws + WS_CIN), (float*)(ws + WS_BA), SSB};
        pg8::gemm_phase<pg8::EpiInProj, pg8::StaticOrder, true, true>(F.lds + RING_OFF, g, S, E);
    } SEAM(3);
    if (IN(4)) { PHASE_PTRS PHASE_FRAME p4_prep(Fp); } SEAM(4);
    if (IN(5)) { PHASE_PTRS PHASE_FRAME p5_scan(Fp); } SEAM(5);
    if (IN(6)) { PHASE_PTRS
        pg8::Gemm g{UA, (const bf16*)(ws + WS_WOUT), MPAD, D, D}; pg8::StaticOrder S; S.init(MPAD, D, F.G, (int)blockIdx.x);
        pg8::EpiResid E{H, U3, SSA, 1.0f, 0, nullptr, nullptr, nullptr};
        pg8::gemm_phase<pg8::EpiResid, pg8::StaticOrder, true, true>(F.lds + RING_OFF, g, S, E);
    } SEAM(6);
    if (IN(7)) { PHASE_PTRS
        pg8::Gemm g{U3, (const bf16*)(ws + WS_W13B), MPAD, 5632, D}; pg8::StaticOrder S; S.init(MPAD, 5632, F.G, (int)blockIdx.x);
        pg8::EpiSwiGLU E{HID, SSA};
        pg8::gemm_phase<pg8::EpiSwiGLU, pg8::StaticOrder, true, true>(F.lds + RING_OFF, g, S, E);
    } SEAM(7);
    if (IN(8)) { PHASE_PTRS
        pg8::Gemm g{HID, (const bf16*)(ws + WS_W2B), MPAD, D, DFF}; pg8::StaticOrder S; S.init(MPAD, D, F.G, (int)blockIdx.x);
        pg8::EpiResid E{H, nullptr, nullptr, 0.5f, 0, nullptr, nullptr, nullptr};
        pg8::gemm_phase<pg8::EpiResid, pg8::StaticOrder, true, true>(F.lds + RING_OFF, g, S, E);
    } SEAM(8);
    if (IN(9)) { PHASE_PTRS PHASE_FRAME p9_final(Fp); }
#undef IN
#undef SEAM
}

extern "C" void kernel_launch(void* const* d_in, const int* in_sizes, int n_in, void* d_out, int out_size, void* d_ws, size_t ws_size, hipStream_t stream) {
    static int grid = 0;
    if (grid == 0) {
        if (n_in != 25 || out_size != (int)OUT_TOTAL || ws_size < WS_END) { fprintf(stderr, "kernel_launch: unexpected shapes (n_in %d, out %d, ws %zu); nothing launched\n", n_in, out_size, ws_size); grid = -1; return; }
        int dev = 0, cus = 0, per_cu = 0;
        if (hipGetDevice(&dev) != hipSuccess || hipDeviceGetAttribute(&cus, hipDeviceAttributeMultiprocessorCount, dev) != hipSuccess) { grid = -1; return; }
        if (hipFuncSetAttribute((const void*)mk_fwd, hipFuncAttributeMaxDynamicSharedMemorySize, LDS_BYTES) != hipSuccess) { fprintf(stderr, "kernel_launch: hipFuncSetAttribute failed\n"); grid = -1; return; }
        if (hipOccupancyMaxActiveBlocksPerMultiprocessor(&per_cu, (const void*)mk_fwd, NWAVES * 64, LDS_BYTES) != hipSuccess || per_cu < 1)
            fprintf(stderr, "kernel_launch: note: occupancy query reports %d workgroups per CU\n", per_cu);
        (void)hipGetLastError();
        grid = cus;
    }
    if (grid < 0) return;
    if (hipMemsetAsync((char*)d_ws + WS_CTL, 0, CTL_ZERO_BYTES, stream) != hipSuccess) { fprintf(stderr, "kernel_launch: hipMemsetAsync failed\n"); return; }
    Args a{};
    for (int i = 0; i < 25; ++i) a.in[i] = (const float*)d_in[i];
    a.out = (float*)d_out; a.ws = (unsigned char*)d_ws;
    for (int li = 0; li < N_LAUNCHES; ++li) {
        a.ph_lo = (N_LAUNCHES == 1) ? 0 : li; a.ph_hi = (N_LAUNCHES == 1) ? NPHASES : li + 1; a.li = li;
        hipLaunchKernelGGL(mk_fwd, dim3(grid), dim3(NWAVES * 64), LDS_BYTES, stream, a);
        const hipError_t le = hipPeekAtLastError();
        if (le != hipSuccess) { fprintf(stderr, "kernel_launch: launch %d failed: %s\n", li, hipGetErrorName(le)); break; }
    }
}
```
